# Optimizing an MI355X kernel written in HIP

```python
import math
import jax
import jax.numpy as jnp
from jax import lax
import numpy as np

D_MODEL = 1024
BATCH = 32
SEQ = 256
DEPTH = 2
DEC_BATCH = 2
DEC_SEQ = 2048
PAST_LEN = 512

GRID_W = 64
N_ATTN_LAYERS = (DEPTH + 1) // 2
N_CONV_LAYERS = DEPTH // 2
N_MOD = 9
D_FF = 2816
EPS = 1e-6
MLA_HEADS = 8
Q_LORA = 384
KV_LORA = 256
NOPE_DIM = 64
ROPE_DIM = 32
V_DIM = 64
QK_DIM = NOPE_DIM + ROPE_DIM
ROPE_BASE = 10000.0
Q_BLOCK = 128
S5_WIDTH = D_MODEL // 2
S5_GROUP = 16
S5_GROUPS = S5_WIDTH // S5_GROUP
S5_STATE = 64
S5_DIRS = 2
DT_MIN = 0.001
DT_MAX = 0.1
LAMBDA_RE_MAX = -1e-4
AB_IN = Q_LORA + KV_LORA + ROPE_DIM + S5_WIDTH
AB_OUT = MLA_HEADS * V_DIM + S5_WIDTH
CONV_WIDTH = D_MODEL
CONV_K = 3

kernel_name = 'hybrid_diffusion_mla_s5_shortconv_step'


def rms_norm(x, g):
    xf = x.astype(jnp.float32)
    y = xf * lax.rsqrt(jnp.mean(xf * xf, axis=-1, keepdims=True) + EPS)
    return (y * g.astype(jnp.float32)).astype(x.dtype)


def modulate(x, g, shift, scale):
    return rms_norm(x, g) * (1 + scale) + shift


def swiglu(h, w_gate, w_up, w_down):
    return (jax.nn.silu(h @ w_gate) * (h @ w_up)) @ w_down


def grid_positions(length):
    rows = length // GRID_W
    row = jnp.repeat(jnp.arange(rows, dtype=jnp.float32), GRID_W)
    col = (jnp.arange(rows * GRID_W) % GRID_W).astype(jnp.float32)
    return row, col


def axial_rope(x):
    row, col = grid_positions(x.shape[1])
    half = ROPE_DIM // 2
    quarter = half // 2
    inv_freq = ROPE_BASE ** (-jnp.arange(quarter, dtype=jnp.float32) / quarter)

    def rotate(xa, pos):
        ang = pos[:, None] * inv_freq[None, :]
        cos = jnp.cos(ang)[None, :, None, :]
        sin = jnp.sin(ang)[None, :, None, :]
        xa = xa.astype(jnp.float32)
        x1, x2 = xa[..., :quarter], xa[..., quarter:]
        return jnp.concatenate([x1 * cos - x2 * sin, x1 * sin + x2 * cos], axis=-1)

    out = jnp.concatenate([rotate(x[..., :half], row), rotate(x[..., half:], col)], axis=-1)
    return out.astype(x.dtype)


def mla_queries(cq, g_q_lat, w_uq, g_qn, rotate):
    b, l, _ = cq.shape
    q = (rms_norm(cq, g_q_lat) @ w_uq).reshape(b, l, MLA_HEADS, QK_DIM)
    q = rms_norm(q, g_qn)
    if rotate:
        q = jnp.concatenate([q[..., :NOPE_DIM], axial_rope(q[..., NOPE_DIM:])], axis=-1)
    return q


def mla_keys_values(ckv, kr, w_ukv, g_kn, rotate):
    b, l, _ = ckv.shape
    kv = (ckv @ w_ukv).reshape(b, l, MLA_HEADS, NOPE_DIM + V_DIM)
    k_nope, v = kv[..., :NOPE_DIM], kv[..., NOPE_DIM:]
    k_rope = jnp.broadcast_to(kr[:, :, None, :], (b, l, MLA_HEADS, ROPE_DIM)).astype(k_nope.dtype)
    k = rms_norm(jnp.concatenate([k_nope, k_rope], axis=-1), g_kn)
    if rotate:
        k = jnp.concatenate([k[..., :NOPE_DIM], axial_rope(k[..., NOPE_DIM:])], axis=-1)
    return k, v


def blocked_attention(q, k, v):
    b, lq, h, dh = q.shape
    n_blocks = lq // Q_BLOCK
    qb = q.reshape(b, n_blocks, Q_BLOCK, h, dh).transpose(1, 0, 2, 3, 4)
    scale = dh ** -0.5

    def one_block(q_blk):
        s = jnp.einsum('bqhd,bkhd->bhqk', q_blk, k).astype(jnp.float32) * scale
        p = jax.nn.softmax(s, axis=-1).astype(v.dtype)
        return jnp.einsum('bhqk,bkhd->bqhd', p, v)

    o = lax.map(one_block, qb)
    return o.transpose(1, 0, 2, 3, 4).reshape(b, lq, h, v.shape[-1])


def complex_linear_combine(e1, e2):
    a1r, a1i, b1r, b1i = e1
    a2r, a2i, b2r, b2i = e2
    ar = a2r * a1r - a2i * a1i
    ai = a2r * a1i + a2i * a1r
    br = a2r * b1r - a2i * b1i + b2r
    bi = a2r * b1i + a2i * b1r + b2i
    return ar, ai, br, bi


def s5_direction(u, lam_re, lam_im, log_dt, b_re, b_im, c_re, c_im, h0, reverse):
    dt = jnp.exp(log_dt)[:, None]
    lr = jnp.minimum(lam_re, LAMBDA_RE_MAX)
    li = lam_im
    mag = jnp.exp(lr * dt)
    ang = li * dt
    ab_re = mag * jnp.cos(ang)
    ab_im = mag * jnp.sin(ang)
    den = lr * lr + li * li
    nr = ab_re - 1.0
    ni = ab_im
    co_re = (nr * lr + ni * li) / den
    co_im = (ni * lr - nr * li) / den
    bb_re = co_re[..., None] * b_re - co_im[..., None] * b_im
    bb_im = co_re[..., None] * b_im + co_im[..., None] * b_re
    if reverse:
        u = jnp.flip(u, axis=1)
    bu_re = jnp.einsum('blgi,gpi->blgp', u, bb_re)
    bu_im = jnp.einsum('blgi,gpi->blgp', u, bb_im)
    if h0 is not None:
        h_re, h_im = h0
        bu_re = bu_re.at[:, 0].add(ab_re * h_re - ab_im * h_im)
        bu_im = bu_im.at[:, 0].add(ab_re * h_im + ab_im * h_re)
    a_re = jnp.broadcast_to(ab_re, bu_re.shape)
    a_im = jnp.broadcast_to(ab_im, bu_im.shape)
    _, _, s_re, s_im = lax.associative_scan(complex_linear_combine, (a_re, a_im, bu_re, bu_im), axis=1)
    y = jnp.einsum('blgp,gip->blgi', s_re, c_re) - jnp.einsum('blgp,gip->blgi', s_im, c_im)
    if reverse:
        y = jnp.flip(y, axis=1)
    return y, s_re[:, -1], s_im[:, -1]


def s5_layer(u, lam_re, lam_im, log_dt, b_re, b_im, c_re, c_im, d_skip, w_glu, b_glu, h0_re, h0_im):
    b, l, _ = u.shape
    f32 = jnp.float32
    uf = u.astype(f32)
    ug = uf.reshape(b, l, S5_GROUPS, S5_GROUP)
    y = d_skip.astype(f32) * uf
    fin_re, fin_im = [], []
    for dr in range(S5_DIRS):
        h0 = None if h0_re is None else (h0_re[:, dr].astype(f32), h0_im[:, dr].astype(f32))
        y_dir, f_re, f_im = s5_direction(ug, lam_re[dr].astype(f32), lam_im[dr].astype(f32), log_dt[dr].astype(f32),
                                         b_re[dr].astype(f32), b_im[dr].astype(f32), c_re[dr].astype(f32),
                                         c_im[dr].astype(f32), h0, dr == 1)
        y = y + y_dir.reshape(b, l, S5_WIDTH)
        fin_re.append(f_re)
        fin_im.append(f_im)
    z = jax.nn.gelu(y)
    out = z * jax.nn.sigmoid(z @ w_glu.astype(f32) + b_glu.astype(f32))
    return out.astype(u.dtype), jnp.stack(fin_re, axis=1).astype(u.dtype), jnp.stack(fin_im, axis=1).astype(u.dtype)


def ab_mixer(hn, ctx_ckv, ctx_kr, h0_re, h0_im, w_in, g_q_lat, g_kv_lat, w_uq, w_ukv, g_qn, g_kn,
             lam_re, lam_im, log_dt, b_re, b_im, c_re, c_im, d_skip, w_glu, b_glu, w_out):
    latent = ctx_ckv is not None
    b, l, _ = hn.shape
    proj = hn @ w_in
    o1 = Q_LORA
    o2 = o1 + KV_LORA
    o3 = o2 + ROPE_DIM
    cq, ckv_raw, kr, u = proj[..., :o1], proj[..., o1:o2], proj[..., o2:o3], proj[..., o3:]
    ckv = rms_norm(ckv_raw, g_kv_lat)
    q = mla_queries(cq, g_q_lat, w_uq, g_qn, latent)
    k, v = mla_keys_values(ckv, kr, w_ukv, g_kn, latent)
    if latent:
        k_c, v_c = mla_keys_values(ctx_ckv, ctx_kr, w_ukv, g_kn, False)
        k = jnp.concatenate([k_c.astype(k.dtype), k], axis=1)
        v = jnp.concatenate([v_c.astype(v.dtype), v], axis=1)
    attn = blocked_attention(q, k, v).reshape(b, l, MLA_HEADS * V_DIM)
    s5_out, fin_re, fin_im = s5_layer(u, lam_re, lam_im, log_dt, b_re, b_im, c_re, c_im, d_skip, w_glu, b_glu,
                                      h0_re, h0_im)
    out = jnp.concatenate([attn, s5_out.astype(attn.dtype)], axis=-1) @ w_out
    return out, ckv, kr, fin_re, fin_im


def conv_mixer(hn, w_in, conv_w, w_out):
    gate_b, gate_c, h = jnp.split(hn @ w_in, 3, axis=-1)
    z = gate_c * h
    rhs = conv_w.T[:, None, :].astype(z.dtype)
    zc = lax.conv_general_dilated(z, rhs, window_strides=(1,), padding=[(CONV_K // 2, CONV_K // 2)],
                                  dimension_numbers=('NWC', 'WIO', 'NWC'), feature_group_count=CONV_WIDTH)
    return (gate_b * zc) @ w_out


def setup_inputs(seed: int = 0) -> dict:
    key = jax.random.key(seed)
    ks = iter(jax.random.split(key, 40))
    f32 = jnp.float32

    def nrm(shape, scale):
        return jax.random.normal(next(ks), shape, f32) * scale

    na, nc = N_ATTN_LAYERS, N_CONV_LAYERS
    lam_im_init = jnp.pi * jnp.arange(S5_STATE, dtype=f32)
    return {
        'x_prompt': nrm((BATCH, SEQ, D_MODEL), 1.0),
        'x_sample': nrm((DEC_BATCH, DEC_SEQ, D_MODEL), 1.0),
        'cache_ckv': nrm((DEC_BATCH, na, PAST_LEN, KV_LORA), 1.0),
        'cache_krope': nrm((DEC_BATCH, na, PAST_LEN, ROPE_DIM), 1.0),
        'state_ssm_re': nrm((DEC_BATCH, na, S5_DIRS, S5_GROUPS, S5_STATE), 1.0),
        'state_ssm_im': nrm((DEC_BATCH, na, S5_DIRS, S5_GROUPS, S5_STATE), 1.0),
        'c': nrm((DEC_BATCH, D_MODEL), 1.0),
        'c_ctx': nrm((D_MODEL,), 1.0),
        'w_ada': nrm((DEPTH, D_MODEL, N_MOD * D_MODEL), 0.5 * D_MODEL ** -0.5),
        'b_ada': nrm((DEPTH, N_MOD * D_MODEL), 0.02),
        'norm_g': 1.0 + nrm((DEPTH, 3, D_MODEL), 0.01),
        'ffn_w_gate': nrm((DEPTH, 2, D_MODEL, D_FF), D_MODEL ** -0.5),
        'ffn_w_up': nrm((DEPTH, 2, D_MODEL, D_FF), D_MODEL ** -0.5),
        'ffn_w_down': nrm((DEPTH, 2, D_FF, D_MODEL), D_FF ** -0.5),
        'ab_w_in': nrm((na, D_MODEL, AB_IN), D_MODEL ** -0.5),
        'mla_g_q_lat': 1.0 + nrm((na, Q_LORA), 0.01),
        'mla_g_kv_lat': 1.0 + nrm((na, KV_LORA), 0.01),
        'mla_w_uq': nrm((na, Q_LORA, MLA_HEADS * QK_DIM), Q_LORA ** -0.5),
        'mla_w_ukv': nrm((na, KV_LORA, MLA_HEADS * (NOPE_DIM + V_DIM)), KV_LORA ** -0.5),
        'mla_g_qnorm': 1.0 + nrm((na, QK_DIM), 0.01),
        'mla_g_knorm': 1.0 + nrm((na, QK_DIM), 0.01),
        's5_lam_re': -0.5 + nrm((na, S5_DIRS, S5_GROUPS, S5_STATE), 0.01),
        's5_lam_im': lam_im_init + nrm((na, S5_DIRS, S5_GROUPS, S5_STATE), 0.01),
        's5_log_dt': jax.random.uniform(next(ks), (na, S5_DIRS, S5_GROUPS), f32,
                                        minval=math.log(DT_MIN), maxval=math.log(DT_MAX)),
        's5_b_re': nrm((na, S5_DIRS, S5_GROUPS, S5_STATE, S5_GROUP), (0.5 / S5_GROUP) ** 0.5),
        's5_b_im': nrm((na, S5_DIRS, S5_GROUPS, S5_STATE, S5_GROUP), (0.5 / S5_GROUP) ** 0.5),
        's5_c_re': nrm((na, S5_DIRS, S5_GROUPS, S5_GROUP, S5_STATE), (0.5 / S5_STATE) ** 0.5),
        's5_c_im': nrm((na, S5_DIRS, S5_GROUPS, S5_GROUP, S5_STATE), (0.5 / S5_STATE) ** 0.5),
        's5_d': nrm((na, S5_WIDTH), 0.5),
        's5_w_glu': nrm((na, S5_WIDTH, S5_WIDTH), S5_WIDTH ** -0.5),
        's5_b_glu': nrm((na, S5_WIDTH), 0.02),
        'ab_w_out': nrm((na, AB_OUT, D_MODEL), AB_OUT ** -0.5),
        'conv_w_in': nrm((nc, D_MODEL, 3 * CONV_WIDTH), D_MODEL ** -0.5),
        'conv_w': nrm((nc, CONV_WIDTH, CONV_K), CONV_K ** -0.5),
        'conv_w_out': nrm((nc, CONV_WIDTH, D_MODEL), CONV_WIDTH ** -0.5),
    }


def reference(x_prompt, x_sample, cache_ckv, cache_krope, state_ssm_re, state_ssm_im, c, c_ctx,
              w_ada, b_ada, norm_g, ffn_w_gate, ffn_w_up, ffn_w_down,
              ab_w_in, mla_g_q_lat, mla_g_kv_lat, mla_w_uq, mla_w_ukv, mla_g_qnorm, mla_g_knorm,
              s5_lam_re, s5_lam_im, s5_log_dt, s5_b_re, s5_b_im, s5_c_re, s5_c_im, s5_d, s5_w_glu, s5_b_glu,
              ab_w_out, conv_w_in, conv_w, conv_w_out):

    def trunk(x, cond, use_cache):
        ckv_list, kr_list, sre_list, sim_list = [], [], [], []
        for l in range(DEPTH):
            mods = (jax.nn.silu(cond) @ w_ada[l] + b_ada[l]).reshape(cond.shape[0], N_MOD, 1, D_MODEL)
            h = modulate(x, norm_g[l, 0], mods[:, 0], mods[:, 1])
            x = x + 0.5 * mods[:, 2] * swiglu(h, ffn_w_gate[l, 0], ffn_w_up[l, 0], ffn_w_down[l, 0])
            h = modulate(x, norm_g[l, 1], mods[:, 3], mods[:, 4])
            if l % 2 == 0:
                a = l // 2
                if use_cache:
                    ctx_ckv, ctx_kr = cache_ckv[:, a], cache_krope[:, a]
                    h0_re, h0_im = state_ssm_re[:, a], state_ssm_im[:, a]
                else:
                    ctx_ckv, ctx_kr, h0_re, h0_im = None, None, None, None
                mix, ckv, kr, f_re, f_im = ab_mixer(
                    h, ctx_ckv, ctx_kr, h0_re, h0_im, ab_w_in[a], mla_g_q_lat[a], mla_g_kv_lat[a], mla_w_uq[a],
                    mla_w_ukv[a], mla_g_qnorm[a], mla_g_knorm[a], s5_lam_re[a], s5_lam_im[a], s5_log_dt[a],
                    s5_b_re[a], s5_b_im[a], s5_c_re[a], s5_c_im[a], s5_d[a], s5_w_glu[a], s5_b_glu[a], ab_w_out[a])
                if not use_cache:
                    ckv_list.append(ckv)
                    kr_list.append(kr)
                    sre_list.append(f_re)
                    sim_list.append(f_im)
            else:
                m = l // 2
                mix = conv_mixer(h, conv_w_in[m], conv_w[m], conv_w_out[m])
            x = x + mods[:, 5] * mix
            h = modulate(x, norm_g[l, 2], mods[:, 6], mods[:, 7])
            x = x + 0.5 * mods[:, 8] * swiglu(h, ffn_w_gate[l, 1], ffn_w_up[l, 1], ffn_w_down[l, 1])
        return x, ckv_list, kr_list, sre_list, sim_list

    y_prompt, ckv_l, kr_l, sre_l, sim_l = trunk(x_prompt, c_ctx[None, :], False)
    new_ckv = jnp.stack(ckv_l, axis=1)
    new_krope = jnp.stack(kr_l, axis=1)
    new_ssm_re = jnp.stack(sre_l, axis=1)
    new_ssm_im = jnp.stack(sim_l, axis=1)
    y_sample, _, _, _, _ = trunk(x_sample, c, True)
    return (y_prompt, y_sample, new_ckv, new_krope, new_ssm_re, new_ssm_im)
```

```cpp
#include <hip/hip_runtime.h>
#include <hip/hip_cooperative_groups.h>
#include <cstdio>
#include <cstdint>
namespace cg = cooperative_groups;
#ifndef MK_MULTI
#define MK_MULTI 0
#endif
namespace pg8 {
#define PG8_LAS __attribute__((address_space(3)))
typedef unsigned short bf16_t;
typedef short bf16x8 __attribute__((ext_vector_type(8)));
typedef float f32x4 __attribute__((ext_vector_type(4)));
typedef unsigned u32x4 __attribute__((ext_vector_type(4)));
constexpr int BM = 256, BK = 64, HALF = 128, HTB = HALF * BK * 2  , STAGE_BYTES = 8 * HTB, NXCD = 8, WGM = 8;

__host__ __device__ __forceinline__ int lds_byte(int r, int c) { const int st = (r >> 4) * 2 + (c >> 5), rr = r & 15, cc = c & 31, ob = rr * 64 + cc * 2; return st * 1024 + (ob ^ (((ob >> 9) & 1) << 5)); }
__host__ __device__ __forceinline__ void stage_rc(int b, int& R, int& C) { const int st = b / 1024, sb = b % 1024, swz = sb ^ (((sb >> 9) & 1) << 5); R = (st >> 1) * 16 + swz / 64; C = (st & 1) * 32 + (swz % 64) / 2; }
__host__ __device__ __forceinline__ int perm32(int rho) { const int n = rho >> 4, i = rho & 15; return 8 * (i >> 2) + 4 * n + (i & 3); }

struct Unit { int pm, pn; };
struct Gemm { const bf16_t* A; const bf16_t* Bt; int M, N, K; };

struct StaticOrder {
    int nM, nN, nwg, G, c;
    __host__ __device__ void init(int M, int N, int G_, int c_) { nM = M / BM; nN = N / BM; nwg = nM * nN; G = G_; c = c_; }
    __host__ __device__ bool next(int i, Unit& u) const {
        const long L = (long)i * G + c; if (L >= nwg) return false;
        int wgid = (int)L; { const int q = nwg / NXCD, r = nwg % NXCD, xcd = wgid % NXCD, off = wgid / NXCD; wgid = (xcd < r ? xcd * (q + 1) : r * (q + 1) + (xcd - r) * q) + off; }
        const int nig = WGM * nN, gid = wgid / nig, fm = gid * WGM, gsz = (nM - fm) < WGM ? (nM - fm) : WGM;
        u.pm = fm + ((wgid % nig) % gsz); u.pn = (wgid % nig) / gsz; return true;
    }
    __device__ __forceinline__ void a_ready(const Unit&) const {}
    __device__ __forceinline__ void done(const Unit&) const {}
};

__device__ __forceinline__ unsigned cvt_pk_bf16(float lo, float hi) { unsigned r; asm volatile("v_cvt_pk_bf16_f32 %0, %1, %2" : "=v"(r) : "v"(lo), "v"(hi)); return r; }
typedef float f32x2 __attribute__((ext_vector_type(2)));
template <class Epi, class Sched, bool ALIGN_EPI = false, bool SP2 = false>
__device__ __forceinline__ void gemm_phase(PG8_LAS unsigned char* lds, const Gemm g, const Sched& S, const Epi& E, int tid_in) {
    const int tid = tid_in, wid = __builtin_amdgcn_readfirstlane(tid >> 6), lane = tid & 63, wr = wid >> 2, wc = wid & 3, fr = lane & 15, fq = lane >> 4;
    const int K = g.K, nt = K / BK;
    unsigned voffA[2], voffB[2];
#pragma unroll
    for (int i = 0; i < 2; ++i) { int R, C; stage_rc(tid * 16 + i * 8192, R, C); const int Rb = Epi::PERM ? ((R & ~31) + perm32(R & 31)) : R;
        voffA[i] = (unsigned)(R * K + C) * 2u; voffB[i] = (unsigned)(Rb * K + C) * 2u; }
    const size_t kstep = (size_t)(BK * 2);
    const size_t hstep = (size_t)HALF * K * 2;
    const size_t tstep = 2 * hstep;
    const unsigned ldsw = (unsigned)wid * 1024u;
    const int aoff = lds_byte(wr * 64 + fr, fq * 8), boff = lds_byte(wc * 32 + fr, fq * 8);
#define PG8_SA(b, h) (((b) * 2 + (h)) * HTB)
#define PG8_SB(b, h) ((4 + (b) * 2 + (h)) * HTB)
#define PG8_STAGE(bufoff, gbase, voff) do { _Pragma("unroll") for (int _i = 0; _i < 2; ++_i) \
        __builtin_amdgcn_global_load_lds((const unsigned*)((const char*)(gbase) + (voff)[_i]), (PG8_LAS unsigned*)(lds + (bufoff) + ldsw + _i * 8192), 16, 0, 0); } while (0)
#define PG8_LDA(dst, b, h) do { _Pragma("unroll") for (int m = 0; m < 4; ++m) _Pragma("unroll") for (int k = 0; k < 2; ++k) dst[m][k] = *(const PG8_LAS bf16x8*)(lds + PG8_SA(b, h) + aoff + m * 2048 + k * 1024); } while (0)
#define PG8_LDB(dst, b, h) do { _Pragma("unroll") for (int n = 0; n < 2; ++n) _Pragma("unroll") for (int k = 0; k < 2; ++k) dst[n][k] = *(const PG8_LAS bf16x8*)(lds + PG8_SB(b, h) + boff + n * 2048 + k * 1024); } while (0)
#define PG8_MMA(ai, bj, At, Bt) do { __builtin_amdgcn_s_setprio(1); _Pragma("unroll") for (int m = 0; m < 4; ++m) _Pragma("unroll") for (int n = 0; n < 2; ++n) _Pragma("unroll") for (int k = 0; k < 2; ++k) \
        acc[ai][bj][m][n] = __builtin_amdgcn_mfma_f32_16x16x32_bf16(Bt[n][k], At[m][k], acc[ai][bj][m][n], 0, 0, 0); __builtin_amdgcn_s_setprio(0); } while (0)
#define PG8_WAIT_V(n) asm volatile("s_waitcnt vmcnt(" #n ")" ::: "memory")
#define PG8_WAIT_L(n) asm volatile("s_waitcnt lgkmcnt(" #n ")" ::: "memory")
#define PG8_BAR __builtin_amdgcn_s_barrier()
#define PG8_SCHED __builtin_amdgcn_sched_barrier(0)
    Unit cur, nxt; int ui = 0;
    if (!S.next(0, cur)) return;
    f32x4 acc[2][2][4][2];
#pragma unroll
    for (int a = 0; a < 2; ++a)
#pragma unroll
        for (int b = 0; b < 2; ++b)
#pragma unroll
            for (int m = 0; m < 4; ++m)
#pragma unroll
                for (int n = 0; n < 2; ++n) acc[a][b][m][n] = (f32x4){0.f, 0.f, 0.f, 0.f};
    bf16x8 At[4][2], B0[2][2], B1[2][2];
    const char* cA = (const char*)g.A + (size_t)cur.pm * tstep; const char* cB = (const char*)g.Bt + (size_t)cur.pn * tstep;
    S.a_ready(cur);
    if constexpr (SP2) {
        PG8_STAGE(PG8_SB(0, 0), cB, voffB); PG8_STAGE(PG8_SB(0, 1), cB + hstep, voffB); PG8_STAGE(PG8_SA(0, 0), cA, voffA); PG8_STAGE(PG8_SA(0, 1), cA + hstep, voffA);
        if (wr == 1) PG8_BAR;
        PG8_WAIT_V(2); PG8_BAR;
        PG8_STAGE(PG8_SB(1, 0), cB + kstep, voffB); PG8_STAGE(PG8_SA(1, 0), cA + kstep, voffA); PG8_STAGE(PG8_SB(1, 1), cB + hstep + kstep, voffB);
        PG8_WAIT_V(6); PG8_BAR;
    } else {
        PG8_STAGE(PG8_SB(0, 0), cB, voffB); PG8_STAGE(PG8_SA(0, 0), cA, voffA); PG8_STAGE(PG8_SB(0, 1), cB + hstep, voffB); PG8_STAGE(PG8_SA(0, 1), cA + hstep, voffA);
        if (wr == 1) PG8_BAR;
        PG8_WAIT_V(4); PG8_BAR;
        PG8_STAGE(PG8_SB(1, 0), cB + kstep, voffB); PG8_STAGE(PG8_SA(1, 0), cA + kstep, voffA); PG8_STAGE(PG8_SB(1, 1), cB + hstep + kstep, voffB);
        PG8_WAIT_V(6); PG8_BAR;
    }
    for (;;) {
        const bool has_next = S.next(ui + 1, nxt);
        const char* nA = has_next ? (const char*)g.A + (size_t)nxt.pm * tstep : cA; const char* nB = has_next ? (const char*)g.Bt + (size_t)nxt.pn * tstep : cB;
        for (int t = 0; t < nt; t += 2) {
            const bool last = (t == nt - 2);
            const char* a1 = cA + (size_t)(t + 1) * kstep;
            const char* a2 = last ? nA : cA + (size_t)(t + 2) * kstep; const char* b2 = last ? nB : cB + (size_t)(t + 2) * kstep;
            const char* a3 = a2 + kstep; const char* b3 = b2 + kstep;
            if (last && has_next) S.a_ready(nxt);
            if constexpr (SP2) {
            PG8_LDB(B0, 0, 0); PG8_LDB(B1, 0, 1); PG8_SCHED; PG8_LDA(At, 0, 0); PG8_STAGE(PG8_SA(1, 1), a1 + hstep, voffA);
            PG8_WAIT_V(8); PG8_WAIT_L(0); PG8_BAR; PG8_MMA(0, 0, At, B0); PG8_MMA(0, 1, At, B1); PG8_BAR; PG8_SCHED;
            PG8_LDA(At, 0, 1); PG8_STAGE(PG8_SB(0, 0), b2, voffB); PG8_STAGE(PG8_SB(0, 1), b2 + hstep, voffB); PG8_STAGE(PG8_SA(0, 0), a2, voffA);
            PG8_WAIT_V(8); PG8_WAIT_L(0); PG8_BAR; PG8_MMA(1, 0, At, B0); PG8_MMA(1, 1, At, B1); PG8_BAR; PG8_SCHED;
            PG8_LDB(B0, 1, 0); PG8_LDB(B1, 1, 1); PG8_SCHED; PG8_LDA(At, 1, 0); PG8_STAGE(PG8_SA(0, 1), a2 + hstep, voffA);
            PG8_WAIT_V(8); PG8_WAIT_L(0); PG8_BAR; PG8_MMA(0, 0, At, B0); PG8_MMA(0, 1, At, B1); PG8_BAR; PG8_SCHED;
            PG8_LDA(At, 1, 1); PG8_STAGE(PG8_SB(1, 0), b3, voffB); PG8_STAGE(PG8_SB(1, 1), b3 + hstep, voffB); PG8_STAGE(PG8_SA(1, 0), a3, voffA);
            PG8_WAIT_V(8); PG8_WAIT_L(0); PG8_BAR; PG8_MMA(1, 0, At, B0); PG8_MMA(1, 1, At, B1); PG8_BAR; PG8_SCHED;
            } else {
            PG8_LDB(B0, 0, 0); PG8_SCHED; PG8_LDA(At, 0, 0); PG8_STAGE(PG8_SA(1, 1), a1 + hstep, voffA);
            PG8_WAIT_L(8); PG8_BAR; PG8_WAIT_L(0); PG8_MMA(0, 0, At, B0); PG8_BAR; PG8_SCHED;
            PG8_LDB(B1, 0, 1); PG8_STAGE(PG8_SB(0, 0), b2, voffB);
            PG8_BAR; PG8_WAIT_L(0); PG8_MMA(0, 1, At, B1); PG8_BAR;
            PG8_LDA(At, 0, 1); PG8_STAGE(PG8_SA(0, 0), a2, voffA);
            PG8_BAR; PG8_WAIT_L(0); PG8_MMA(1, 0, At, B0); PG8_BAR; PG8_SCHED;
            PG8_STAGE(PG8_SB(0, 1), b2 + hstep, voffB);
            PG8_WAIT_V(6); PG8_BAR; PG8_MMA(1, 1, At, B1); PG8_BAR;
            PG8_LDB(B0, 1, 0); PG8_SCHED; PG8_LDA(At, 1, 0); PG8_STAGE(PG8_SA(0, 1), a2 + hstep, voffA);
            PG8_WAIT_L(8); PG8_BAR; PG8_WAIT_L(0); PG8_MMA(0, 0, At, B0); PG8_BAR; PG8_SCHED;
            PG8_LDB(B1, 1, 1); PG8_STAGE(PG8_SB(1, 0), b3, voffB);
            PG8_BAR; PG8_WAIT_L(0); PG8_MMA(0, 1, At, B1); PG8_BAR;
            PG8_LDA(At, 1, 1); PG8_STAGE(PG8_SA(1, 0), a3, voffA);
            PG8_BAR; PG8_WAIT_L(0); PG8_MMA(1, 0, At, B0); PG8_BAR; PG8_SCHED;
            PG8_STAGE(PG8_SB(1, 1), b3 + hstep, voffB);
            PG8_WAIT_V(6); PG8_BAR; PG8_MMA(1, 1, At, B1); PG8_BAR;
            }
        }
        if constexpr (ALIGN_EPI) { if (wr == 0) PG8_BAR; }
        if constexpr (!Epi::AFTER_DRAIN) { E(acc, cur, wr, wc, fr, fq); S.done(cur); }
        if (!has_next) break;
#pragma unroll
        for (int a = 0; a < 2; ++a)
#pragma unroll
            for (int b = 0; b < 2; ++b)
#pragma unroll
                for (int m = 0; m < 4; ++m)
#pragma unroll
                    for (int n = 0; n < 2; ++n) acc[a][b][m][n] = (f32x4){0.f, 0.f, 0.f, 0.f};
        cur = nxt; cA = nA; cB = nB; ++ui;
        if constexpr (ALIGN_EPI) { if (wr == 1) PG8_BAR; }
    }
    PG8_WAIT_V(0);
    if constexpr (!ALIGN_EPI) { if (wr == 0) PG8_BAR; }
    PG8_BAR;
    if constexpr (Epi::AFTER_DRAIN) { E.fused(acc, cur, wr, wc, fr, fq, lds, wid, lane); S.done(cur); }
#undef PG8_SA
#undef PG8_SB
#undef PG8_STAGE
#undef PG8_LDA
#undef PG8_LDB
#undef PG8_MMA
#undef PG8_WAIT_V
#undef PG8_WAIT_L
#undef PG8_BAR
#undef PG8_SCHED
}
}

using pg8::bf16_t; using pg8::bf16x8; using pg8::f32x4; using pg8::u32x4; using pg8::cvt_pk_bf16; using pg8::Unit;
#define LAS __attribute__((address_space(3)))
typedef float f32x16 __attribute__((ext_vector_type(16)));
typedef unsigned u32x2 __attribute__((ext_vector_type(2)));

constexpr int NTOK = 12288, NPR = 8192, NKV = 13312;
constexpr size_t MiB = 1u << 20;
constexpr size_t WS_MODS = 65536;
constexpr size_t WS_WGU = 2 * MiB, WGU_EL = (size_t)5632 * 1024;
constexpr size_t WS_WD = 46 * MiB, WD_EL = (size_t)1024 * 2816;
constexpr size_t WS_WIN = 68 * MiB, WS_WUQ = 70 * MiB + MiB / 2, WS_WUKV = 71 * MiB + MiB / 4, WS_WGLU = 71 * MiB + 3 * MiB / 4, WS_WOUT = 72 * MiB + MiB / 2,
                 WS_WCIN = 74 * MiB + MiB / 2, WS_WCOUT = 80 * MiB + MiB / 2;
constexpr size_t WS_H = 84 * MiB, WS_BIG = 108 * MiB;
constexpr size_t WS_ACT = WS_BIG, WS_PROJ = WS_BIG, WS_KVRAW = WS_BIG, WS_CQN = WS_BIG + 60 * MiB, WS_CKVN = WS_BIG + 69 * MiB, WS_VT = WS_BIG + 60 * MiB,
                 WS_KR32 = WS_BIG + 76 * MiB, WS_Z = WS_BIG + 78 * MiB, WS_QB = WS_BIG + 78 * MiB, WS_ZB = WS_BIG + 102 * MiB, WS_QRAW = WS_BIG + 114 * MiB, WS_KB = WS_BIG + 150 * MiB;
constexpr size_t WS_ZC = WS_BIG, WS_GB = WS_BIG + 24 * MiB;
constexpr size_t VT_S = (size_t)32 * 8 * 64 * 256;
constexpr int OUT_CKV = 12582912, OUT_KR = 14680064, OUT_SRE = 14942208, OUT_SIM = 15073280;
constexpr int LDS_BYTES = 147456;
constexpr int NPHASE = 24;

#define LDS_WAIT() asm volatile("s_waitcnt lgkmcnt(0)" ::: "memory")
__device__ __forceinline__ float wave_sum(float v) {
#pragma unroll
    for (int o = 1; o < 64; o <<= 1) v += __shfl_xor(v, o);
    return v;
}
__device__ __forceinline__ float bf2f(unsigned short b) { return __uint_as_float((unsigned)b << 16); }
__device__ __forceinline__ u32x4 pack8(f32x4 a, f32x4 b) { u32x4 w; w.x = cvt_pk_bf16(a[0], a[1]); w.y = cvt_pk_bf16(a[2], a[3]); w.z = cvt_pk_bf16(b[0], b[1]); w.w = cvt_pk_bf16(b[2], b[3]); return w; }
__device__ __forceinline__ bf16x8 pack8v(f32x4 a, f32x4 b) { u32x4 w = pack8(a, b); return __builtin_bit_cast(bf16x8, w); }
__device__ __forceinline__ float fexp2(float x) { return __builtin_amdgcn_exp2f(x); }
__device__ __forceinline__ float sigmoidf_(float v) { return __builtin_amdgcn_rcpf(1.0f + fexp2(-1.44269504f * v)); }
__device__ __forceinline__ float gelu_tanh(float v) { const float u = 0.7978845608f * (v + 0.044715f * v * v * v); const float t = 1.0f - 2.0f * __builtin_amdgcn_rcpf(1.0f + fexp2(2.88539008f * u)); return 0.5f * v * (1.0f + t); }
__device__ __forceinline__ void sincos_acc(float x, float& s, float& c) {
    const float n = rintf(x * 0.636619772f);
    float r = fmaf(-n, 1.5707855225e+00f, x); r = fmaf(-n, 1.0804334124e-05f, r);
    const float r2 = r * r;
    const float sp = r + r * r2 * (-1.6666667e-1f + r2 * (8.3333333e-3f + r2 * (-1.9841270e-4f + r2 * 2.7557319e-6f)));
    const float cp = 1.f + r2 * (-0.5f + r2 * (4.1666667e-2f + r2 * (-1.3888889e-3f + r2 * (2.4801587e-5f + r2 * (-2.7557319e-7f)))));
    const int q = ((int)n) & 3;
    s = (q == 0) ? sp : (q == 1) ? cp : (q == 2) ? -sp : -cp;
    c = (q == 0) ? cp : (q == 1) ? -sp : (q == 2) ? -cp : sp;
}
__device__ __forceinline__ int cond_of_row(int row) { return row < NPR ? 0 : 1 + ((row - NPR) >> 11); }

struct EpiSwiGLU {
    static constexpr bool PERM = true, AFTER_DRAIN = false;
    bf16_t* O;
    __device__ __forceinline__ void operator()(const f32x4 (&acc)[2][2][4][2], const Unit& u, int wr, int wc, int fr, int fq) const {
        const int row0 = u.pm * 256 + wr * 64 + fr, col0 = u.pn * 128 + wc * 32 + 8 * fq;
#pragma unroll
        for (int ai = 0; ai < 2; ++ai)
#pragma unroll
            for (int m = 0; m < 4; ++m) {
                f32x4 v[2];
#pragma unroll
                for (int n = 0; n < 2; ++n)
#pragma unroll
                    for (int j = 0; j < 4; ++j) { const float g = acc[ai][0][m][n][j]; v[n][j] = g * sigmoidf_(g) * acc[ai][1][m][n][j]; }
                *(u32x4*)(O + (size_t)(row0 + ai * 128 + m * 16) * 2816 + col0) = pack8(v[0], v[1]);
            }
    }
};
struct EpiResid {
    static constexpr bool PERM = false, AFTER_DRAIN = false;
    float* X; const float* gate; float gs;
    __device__ __forceinline__ void operator()(const f32x4 (&acc)[2][2][4][2], const Unit& u, int wr, int wc, int fr, int fq) const {
        const int cnd = u.pm < 32 ? 0 : 1 + ((u.pm - 32) >> 3);
        const float* gp = gate + cnd * 9216;
        const int row0 = u.pm * 256 + wr * 64 + fr, col0 = u.pn * 256 + wc * 32 + 4 * fq;
#pragma unroll
        for (int bj = 0; bj < 2; ++bj)
#pragma unroll
            for (int n = 0; n < 2; ++n) {
                const int col = col0 + bj * 128 + n * 16;
                const f32x4 gv = *(const f32x4*)(gp + col) * gs;
#pragma unroll
                for (int ai = 0; ai < 2; ++ai)
#pragma unroll
                    for (int m = 0; m < 4; ++m) { float* p = X + (size_t)(row0 + ai * 128 + m * 16) * 1024 + col; f32x4 x = *(const f32x4*)p; x += gv * acc[ai][bj][m][n]; *(f32x4*)p = x; }
            }
    }
};
struct EpiF32 {
    static constexpr bool PERM = false, AFTER_DRAIN = false;
    float* C; int ldc;
    __device__ __forceinline__ void operator()(const f32x4 (&acc)[2][2][4][2], const Unit& u, int wr, int wc, int fr, int fq) const {
        const int row0 = u.pm * 256 + wr * 64 + fr, col0 = u.pn * 256 + wc * 32 + 4 * fq;
#pragma unroll
        for (int ai = 0; ai < 2; ++ai)
#pragma unroll
            for (int m = 0; m < 4; ++m) { float* rp = C + (size_t)(row0 + ai * 128 + m * 16) * ldc + col0;
#pragma unroll
                for (int bj = 0; bj < 2; ++bj)
#pragma unroll
                    for (int n = 0; n < 2; ++n) *(f32x4*)(rp + bj * 128 + n * 16) = acc[ai][bj][m][n]; }
    }
};
struct EpiGLU {
    static constexpr bool PERM = true, AFTER_DRAIN = false;
    const float* Z; const float* bias; bf16_t* O;
    __device__ __forceinline__ void operator()(const f32x4 (&acc)[2][2][4][2], const Unit& u, int wr, int wc, int fr, int fq) const {
        const int row0 = u.pm * 256 + wr * 64 + fr, col0 = u.pn * 256 + wc * 32 + 8 * fq;
#pragma unroll
        for (int bj = 0; bj < 2; ++bj) {
            const int col = col0 + bj * 128;
            const f32x4 b0 = *(const f32x4*)(bias + col), b1 = *(const f32x4*)(bias + col + 4);
#pragma unroll
            for (int ai = 0; ai < 2; ++ai)
#pragma unroll
                for (int m = 0; m < 4; ++m) {
                    const int row = row0 + ai * 128 + m * 16;
                    const f32x4 z0 = *(const f32x4*)(Z + (size_t)row * 512 + col), z1 = *(const f32x4*)(Z + (size_t)row * 512 + col + 4);
                    f32x4 v0, v1;
#pragma unroll
                    for (int j = 0; j < 4; ++j) { v0[j] = z0[j] * sigmoidf_(acc[ai][bj][m][0][j] + b0[j]); v1[j] = z1[j] * sigmoidf_(acc[ai][bj][m][1][j] + b1[j]); }
                    *(u32x4*)(O + (size_t)row * 1024 + col) = pack8(v0, v1);
                }
        }
    }
};
struct EpiConvIn {
    static constexpr bool PERM = true, AFTER_DRAIN = false;
    bf16_t* ZC; bf16_t* GB;
    __device__ __forceinline__ void operator()(const f32x4 (&acc)[2][2][4][2], const Unit& u, int wr, int wc, int fr, int fq) const {
        const int row0 = u.pm * 256 + wr * 64 + fr;
        if (u.pn < 8) {
            const int col0 = u.pn * 128 + wc * 32 + 8 * fq;
#pragma unroll
            for (int ai = 0; ai < 2; ++ai)
#pragma unroll
                for (int m = 0; m < 4; ++m)
                    *(u32x4*)(ZC + (size_t)(row0 + ai * 128 + m * 16) * 1024 + col0) = pack8(acc[ai][0][m][0] * acc[ai][1][m][0], acc[ai][0][m][1] * acc[ai][1][m][1]);
        } else {
            const int col0 = (u.pn - 8) * 256 + wc * 32 + 8 * fq;
#pragma unroll
            for (int ai = 0; ai < 2; ++ai)
#pragma unroll
                for (int m = 0; m < 4; ++m)
#pragma unroll
                    for (int bj = 0; bj < 2; ++bj)
                        *(u32x4*)(GB + (size_t)(row0 + ai * 128 + m * 16) * 1024 + col0 + bj * 128) = pack8(acc[ai][bj][m][0], acc[ai][bj][m][1]);
        }
    }
};

__device__ __forceinline__ void transpose_item(const float* W, int K, int N, bf16_t* WT, int drow0, LAS float* scr, int kb, int n0, int lane) {
    const int k0 = 64 * kb;
#pragma unroll 8
    for (int i = 0; i < 32; ++i) { const int kk = 2 * i + (lane >> 5); scr[kk * 33 + (lane & 31)] = W[(size_t)(k0 + kk) * N + n0 + (lane & 31)]; }
    LDS_WAIT();
    const int c = lane & 7;
#pragma unroll
    for (int j = 0; j < 4; ++j) { const int n = (lane >> 3) + 8 * j; const LAS float* s = scr + (8 * c) * 33 + n;
        u32x4 o; o.x = cvt_pk_bf16(s[0 * 33], s[1 * 33]); o.y = cvt_pk_bf16(s[2 * 33], s[3 * 33]); o.z = cvt_pk_bf16(s[4 * 33], s[5 * 33]); o.w = cvt_pk_bf16(s[6 * 33], s[7 * 33]);
        *(u32x4*)(WT + (size_t)(drow0 + n) * K + k0 + 8 * c) = o; }
    LDS_WAIT();
}
__device__ __forceinline__ int gu_row(int n0, int up) { return 256 * (n0 >> 7) + (n0 & 127) + (up ? 128 : 0); }

__device__ __forceinline__ void phase0(LAS unsigned char* lds, const float* const* in, unsigned char* ws, int tid, int wave, int lane) {
    const int G = gridDim.x;
    LAS float* SIL = (LAS float*)(lds + 69632);
    LAS float* PART = (LAS float*)(lds + 81920);
    for (int i = tid; i < 3072; i += 512) { const int c = i >> 10, k = i & 1023; const float v = (c == 0) ? in[7][k] : in[6][(c - 1) * 1024 + k]; SIL[i] = v * sigmoidf_(v); }
    __syncthreads();
    float* mods = (float*)(ws + WS_MODS);
    for (int item = blockIdx.x; item < 288; item += G) {
        const int l = item / 144, j0 = (item % 144) * 64;
        const float* W = in[8] + (size_t)l * 1024 * 9216 + j0 + lane;
        float a0 = 0.f, a1 = 0.f, a2 = 0.f;
#pragma unroll 16
        for (int kk = 0; kk < 128; ++kk) { const int k = wave * 128 + kk; const float w = W[(size_t)k * 9216]; a0 = fmaf(SIL[k], w, a0); a1 = fmaf(SIL[1024 + k], w, a1); a2 = fmaf(SIL[2048 + k], w, a2); }
        PART[(wave * 3 + 0) * 64 + lane] = a0; PART[(wave * 3 + 1) * 64 + lane] = a1; PART[(wave * 3 + 2) * 64 + lane] = a2;
        __syncthreads();
        if (tid < 192) { const int c = tid >> 6, ln = tid & 63; float s = in[9][l * 9216 + j0 + ln];
#pragma unroll
            for (int w = 0; w < 8; ++w) s += PART[(w * 3 + c) * 64 + ln];
            mods[(size_t)(l * 3 + c) * 9216 + j0 + ln] = s; }
        __syncthreads();
    }
    LAS float* scr = (LAS float*)(lds + wave * 8448);
    const int gw = blockIdx.x * 8 + wave, NGW = G * 8;
    bf16_t* Wgu = (bf16_t*)(ws + WS_WGU); bf16_t* Wd = (bf16_t*)(ws + WS_WD);
    for (int it = gw; it < 20448; it += NGW) {
        int r = it;
        if (r < 16896) {
            const int lf = r / 4224, rr = r % 4224, which = rr / 1408, q = rr % 1408;
            if (which < 2) { const int kb = q / 88, n0 = 32 * (q % 88); transpose_item((which ? in[12] : in[11]) + (size_t)lf * 1024 * 2816, 1024, 2816, Wgu + (size_t)lf * WGU_EL, gu_row(n0, which), scr, kb, n0, lane); }
            else { const int kb = q / 32, n0 = 32 * (q % 32); transpose_item(in[13] + (size_t)lf * 2816 * 1024, 2816, 1024, Wd + (size_t)lf * WD_EL, n0, scr, kb, n0, lane); }
            continue;
        }
        r -= 16896;
        if (r < 592) { transpose_item(in[14], 1024, 1184, (bf16_t*)(ws + WS_WIN), 32 * (r % 37), scr, r / 37, 32 * (r % 37), lane); continue; } r -= 592;
        if (r < 144) { transpose_item(in[17], 384, 768, (bf16_t*)(ws + WS_WUQ), 32 * (r % 24), scr, r / 24, 32 * (r % 24), lane); continue; } r -= 144;
        if (r < 128) { transpose_item(in[18], 256, 1024, (bf16_t*)(ws + WS_WUKV), 32 * (r % 32), scr, r / 32, 32 * (r % 32), lane); continue; } r -= 128;
        if (r < 128) { transpose_item(in[29], 512, 512, (bf16_t*)(ws + WS_WGLU), 32 * (r % 16), scr, r / 16, 32 * (r % 16), lane); continue; } r -= 128;
        if (r < 512) { transpose_item(in[31], 1024, 1024, (bf16_t*)(ws + WS_WOUT), 32 * (r % 32), scr, r / 32, 32 * (r % 32), lane); continue; } r -= 512;
        if (r < 1536) { const int n0 = 32 * (r % 96); const int drow = n0 < 1024 ? 2048 + n0 : (n0 < 2048 ? gu_row(n0 - 1024, 0) : gu_row(n0 - 2048, 1));
            transpose_item(in[32], 1024, 3072, (bf16_t*)(ws + WS_WCIN), drow, scr, r / 96, n0, lane); continue; } r -= 1536;
        transpose_item(in[34], 1024, 1024, (bf16_t*)(ws + WS_WCOUT), 32 * (r % 32), scr, r / 32, 32 * (r % 32), lane);
    }
    { u32x4* zp = (u32x4*)((bf16_t*)(ws + WS_WIN) + (size_t)1184 * 1024); const u32x4 z = {0u, 0u, 0u, 0u};
      for (int i = blockIdx.x * 512 + tid; i < 12288; i += G * 512) zp[i] = z; }
}

__device__ __forceinline__ void normmod_phase(const float* src0, const float* src1, float* xcopy, bf16_t* H, const float* g, const float* mods_l, int si, int wave, int lane) {
    const int gw = blockIdx.x * 8 + wave, NGW = gridDim.x * 8;
    for (int row = gw; row < NTOK; row += NGW) {
        const float* xr = (row < NPR) ? src0 + (size_t)row * 1024 : src1 + (size_t)(row - NPR) * 1024;
        const float* sh = mods_l + cond_of_row(row) * 9216 + (3 * si) * 1024; const float* sc = sh + 1024;
        f32x4 v[4]; float ss = 0.f;
#pragma unroll
        for (int j = 0; j < 4; ++j) { v[j] = *(const f32x4*)(xr + 4 * lane + 256 * j); ss += (v[j][0] * v[j][0] + v[j][1] * v[j][1]) + (v[j][2] * v[j][2] + v[j][3] * v[j][3]); }
        const float rstd = rsqrtf(wave_sum(ss) * (1.0f / 1024.0f) + 1e-6f);
#pragma unroll
        for (int j = 0; j < 4; ++j) {
            const int c = 4 * lane + 256 * j;
            if (xcopy) *(f32x4*)(xcopy + (size_t)row * 1024 + c) = v[j];
            const f32x4 gg = *(const f32x4*)(g + c), s1 = *(const f32x4*)(sc + c), s0 = *(const f32x4*)(sh + c);
            const f32x4 o = v[j] * rstd * gg * (s1 + 1.0f) + s0;
            u32x2 w; w.x = cvt_pk_bf16(o[0], o[1]); w.y = cvt_pk_bf16(o[2], o[3]);
            *(u32x2*)(H + (size_t)row * 1024 + c) = w;
        }
    }
}

__device__ __forceinline__ int kv_row_of_tok(int r) { return r < NPR ? r : NPR + ((r - NPR) >> 11) * 2560 + 512 + ((r - NPR) & 2047); }

__device__ __forceinline__ void post1_rows(const float* const* in, const float* proj, bf16_t* cqn, bf16_t* ckvn, float* kr32, float* out, int wave, int lane) {
    const int gw = blockIdx.x * 8 + wave, NGW = gridDim.x * 8;
    const float* gq = in[15]; const float* gkv = in[16];
    for (int r = gw; r < NTOK + 1024; r += NGW) {
        if (r < NTOK) {
            const float* pr = proj + (size_t)r * 1280;
            float cq[6]; float ss = 0.f;
#pragma unroll
            for (int j = 0; j < 6; ++j) { cq[j] = pr[lane + 64 * j]; ss += cq[j] * cq[j]; }
            const float rq = rsqrtf(wave_sum(ss) * (1.0f / 384.0f) + 1e-6f);
#pragma unroll
            for (int j = 0; j < 6; ++j) { const float o = cq[j] * rq * gq[lane + 64 * j]; cqn[(size_t)r * 384 + lane + 64 * j] = (bf16_t)(cvt_pk_bf16(o, 0.f) & 0xffffu); }
            const f32x4 kv = *(const f32x4*)(pr + 384 + 4 * lane);
            const float rk = rsqrtf(wave_sum((kv[0] * kv[0] + kv[1] * kv[1]) + (kv[2] * kv[2] + kv[3] * kv[3])) * (1.0f / 256.0f) + 1e-6f);
            const f32x4 o = kv * rk * *(const f32x4*)(gkv + 4 * lane);
            const int kvr = kv_row_of_tok(r);
            u32x2 w; w.x = cvt_pk_bf16(o[0], o[1]); w.y = cvt_pk_bf16(o[2], o[3]);
            *(u32x2*)(ckvn + (size_t)kvr * 256 + 4 * lane) = w;
            if (r < NPR) *(f32x4*)(out + OUT_CKV + (size_t)r * 256 + 4 * lane) = o;
            if (lane < 32) { const float kr = pr[640 + lane]; kr32[(size_t)kvr * 32 + lane] = kr; if (r < NPR) out[OUT_KR + (size_t)r * 32 + lane] = kr; }
        } else {
            const int i = r - NTOK, b = i >> 9, j = i & 511, kvr = NPR + b * 2560 + j;
            const f32x4 o = *(const f32x4*)(in[2] + (size_t)i * 256 + 4 * lane);
            u32x2 w; w.x = cvt_pk_bf16(o[0], o[1]); w.y = cvt_pk_bf16(o[2], o[3]);
            *(u32x2*)(ckvn + (size_t)kvr * 256 + 4 * lane) = w;
            if (lane < 32) kr32[(size_t)kvr * 32 + lane] = in[3][(size_t)i * 32 + lane];
        }
    }
}

__device__ __forceinline__ void s5_setup(const float* const* in, int dir, int g, int lane, LAS bf16_t* scrB, float& ar, float& ai, bf16x8 (&BmA)[8], bf16x8 (&CmA)[4]) {
    const int idx = dir * 32 + g, p = lane;
    const float dt = expf(in[23][idx]);
    const float lr = fminf(in[21][idx * 64 + p], -1e-4f), li = in[22][idx * 64 + p];
    const float mag = expf(lr * dt); float sn, cs; sincos_acc(li * dt, sn, cs);
    ar = mag * cs; ai = mag * sn;
    const float den = lr * lr + li * li, nr = ar - 1.0f, ni = ai;
    const float core = (nr * lr + ni * li) / den, coim = (ni * lr - nr * li) / den;
    const float* bre = in[24] + (size_t)(idx * 64 + p) * 16; const float* bim = in[25] + (size_t)(idx * 64 + p) * 16;
#pragma unroll
    for (int h = 0; h < 2; ++h) {
        const f32x4 r0 = *(const f32x4*)(bre + 8 * h), r1 = *(const f32x4*)(bre + 8 * h + 4), i0 = *(const f32x4*)(bim + 8 * h), i1 = *(const f32x4*)(bim + 8 * h + 4);
        *(LAS u32x4*)(scrB + p * 16 + 8 * h) = pack8(r0 * core - i0 * coim, r1 * core - i1 * coim);
        *(LAS u32x4*)(scrB + (64 + p) * 16 + 8 * h) = pack8(i0 * core + r0 * coim, i1 * core + r1 * coim);
    }
    LDS_WAIT();
    const int rw = lane & 15, kq = lane >> 4;
    const bf16x8 zero8 = {0, 0, 0, 0, 0, 0, 0, 0};
#pragma unroll
    for (int blk = 0; blk < 8; ++blk) BmA[blk] = (kq < 2) ? *(const LAS bf16x8*)(scrB + (16 * blk + rw) * 16 + 8 * kq) : zero8;
    LDS_WAIT();
    const float* cre = in[26] + (size_t)(idx * 16 + rw) * 64 + 8 * kq; const float* cim = in[27] + (size_t)(idx * 16 + rw) * 64 + 8 * kq;
#pragma unroll
    for (int kk = 0; kk < 2; ++kk) {
        CmA[kk] = pack8v(*(const f32x4*)(cre + 32 * kk), *(const f32x4*)(cre + 32 * kk + 4));
        CmA[2 + kk] = pack8v(-*(const f32x4*)(cim + 32 * kk), -*(const f32x4*)(cim + 32 * kk + 4));
    }
}

template <bool WANT_Y>
__device__ __forceinline__ void s5_pass(int dir, int g, int tok0, float& sr, float& si, float ar, float ai, const bf16x8 (&BmA)[8], const bf16x8 (&CmA)[4],
                                        const float* proj, float* ybuf, bf16_t* zb, const float* s5d, LAS float* BUs, LAS bf16_t* Sm, int lane) {
    const int tl = lane & 15, kq = lane >> 4;
    const bf16x8 zero8 = {0, 0, 0, 0, 0, 0, 0, 0};
    for (int sc = 0; sc < 16; ++sc) {
        const int sub = dir ? 15 - sc : sc, t0 = tok0 + 16 * sub;
        bf16x8 ub = zero8;
        if (kq < 2) { const float* up = proj + (size_t)(t0 + tl) * 1280 + 672 + 16 * g + 8 * kq; ub = pack8v(*(const f32x4*)up, *(const f32x4*)(up + 4)); }
#pragma unroll
        for (int blk = 0; blk < 8; ++blk) {
            const f32x4 acc = __builtin_amdgcn_mfma_f32_16x16x32_bf16(BmA[blk], ub, (f32x4){0.f, 0.f, 0.f, 0.f}, 0, 0, 0);
            *(LAS f32x4*)(BUs + tl * 132 + 16 * blk + 4 * kq) = acc;
        }
        LDS_WAIT();
#pragma unroll
        for (int tt = 0; tt < 16; ++tt) {
            const int t = dir ? 15 - tt : tt;
            const float br = BUs[t * 132 + lane], bi = BUs[t * 132 + 64 + lane];
            const float nsr = fmaf(ar, sr, fmaf(-ai, si, br)), nsi = fmaf(ar, si, fmaf(ai, sr, bi));
            sr = nsr; si = nsi;
            if (WANT_Y) { const unsigned pk = cvt_pk_bf16(sr, si); Sm[t * 136 + lane] = (bf16_t)(pk & 0xffffu); Sm[t * 136 + 64 + lane] = (bf16_t)(pk >> 16); }
        }
        if (WANT_Y) {
            LDS_WAIT();
            f32x4 y = {0.f, 0.f, 0.f, 0.f};
#pragma unroll
            for (int kk = 0; kk < 4; ++kk) { const bf16x8 sb = *(const LAS bf16x8*)(Sm + tl * 136 + 32 * kk + 8 * kq); y = __builtin_amdgcn_mfma_f32_16x16x32_bf16(CmA[kk], sb, y, 0, 0, 0); }
            const size_t off = (size_t)(t0 + tl) * 512 + 16 * g + 4 * kq;
            if (dir == 0) { *(f32x4*)(ybuf + off) = y; }
            else {
                const f32x4 prev = *(const f32x4*)(ybuf + off), uu = *(const f32x4*)(proj + (size_t)(t0 + tl) * 1280 + 672 + 16 * g + 4 * kq), dd = *(const f32x4*)(s5d + 16 * g + 4 * kq);
                f32x4 v = dd * uu + prev + y;
#pragma unroll
                for (int j = 0; j < 4; ++j) v[j] = gelu_tanh(v[j]);
                *(f32x4*)(ybuf + off) = v;
                u32x2 w; w.x = cvt_pk_bf16(v[0], v[1]); w.y = cvt_pk_bf16(v[2], v[3]);
                *(u32x2*)(zb + off) = w;
            }
            LDS_WAIT();
        }
    }
}

__device__ __forceinline__ void s5_phase(LAS unsigned char* lds, const float* const* in, const float* proj, float* ybuf, bf16_t* zb, float* out, int wave, int lane) {
    LAS float* BUs = (LAS float*)(lds + wave * 12800);
    LAS bf16_t* Sm = (LAS bf16_t*)(lds + wave * 12800 + 8448);
    LAS float* CA = (LAS float*)(lds + 102400);
    const float* s5d = in[28];
    bf16x8 BmA[8], CmA[4]; float ar, ai;
    for (int u = blockIdx.x; u < 192; u += gridDim.x) {
        if (u < 64) {
            const int b = u >> 5, g = u & 31, tok0 = NPR + b * 2048 + 256 * wave;
            for (int dir = 0; dir < 2; ++dir) {
                s5_setup(in, dir, g, lane, (LAS bf16_t*)BUs, ar, ai, BmA, CmA);
                float xr = ar, xi = ai;
#pragma unroll
                for (int q = 0; q < 8; ++q) { const float nr = xr * xr - xi * xi, ni = 2.0f * xr * xi; xr = nr; xi = ni; }
                float sr = 0.f, si = 0.f;
                s5_pass<false>(dir, g, tok0, sr, si, ar, ai, BmA, CmA, proj, ybuf, zb, s5d, BUs, Sm, lane);
                CA[wave * 128 + lane] = sr; CA[wave * 128 + 64 + lane] = si;
                __syncthreads();
                float ir = in[4][(size_t)((b * 2 + dir) * 32 + g) * 64 + lane], ii = in[5][(size_t)((b * 2 + dir) * 32 + g) * 64 + lane];
                if (dir == 0) { for (int c = 0; c < wave; ++c) { const float nr = xr * ir - xi * ii + CA[c * 128 + lane], ni = xr * ii + xi * ir + CA[c * 128 + 64 + lane]; ir = nr; ii = ni; } }
                else { for (int c = 7; c > wave; --c) { const float nr = xr * ir - xi * ii + CA[c * 128 + lane], ni = xr * ii + xi * ir + CA[c * 128 + 64 + lane]; ir = nr; ii = ni; } }
                __syncthreads();
                sr = ir; si = ii;
                s5_pass<true>(dir, g, tok0, sr, si, ar, ai, BmA, CmA, proj, ybuf, zb, s5d, BUs, Sm, lane);
            }
        } else {
            const int id = (u - 64) * 8 + wave, b = id >> 5, g = id & 31, tok0 = b * 256;
            for (int dir = 0; dir < 2; ++dir) {
                s5_setup(in, dir, g, lane, (LAS bf16_t*)BUs, ar, ai, BmA, CmA);
                float sr = 0.f, si = 0.f;
                s5_pass<true>(dir, g, tok0, sr, si, ar, ai, BmA, CmA, proj, ybuf, zb, s5d, BUs, Sm, lane);
                out[OUT_SRE + (size_t)((b * 2 + dir) * 32 + g) * 64 + lane] = sr;
                out[OUT_SIM + (size_t)((b * 2 + dir) * 32 + g) * 64 + lane] = si;
            }
        }
    }
}

constexpr float QSCALE = 0.14724350f;
__device__ __forceinline__ void post2_phase(LAS unsigned char* lds, const float* kvraw, const float* kr32, const float* qraw, const float* gkn, const float* gqn,
                                            bf16_t* Kb, bf16_t* Vt, bf16_t* Qb, int tid, int wave, int lane) {
    LAS bf16_t* Vsm = (LAS bf16_t*)lds;
    LAS float* RC = (LAS float*)(lds + 73728);
    { const int pos = tid >> 3, i = tid & 7; const float invf = fexp2(-(float)i * (13.287712379549449f / 8.0f)); float sn, cs; sincos_acc((float)pos * invf, sn, cs); RC[tid] = cs; RC[512 + tid] = sn; }
    __syncthreads();
    const int h = lane >> 3, j = lane & 7;
    f32x4 gk[4], gq[4];
#pragma unroll
    for (int i = 0; i < 4; ++i) { gk[i] = (j < 6) ? *(const f32x4*)(gkn + 16 * j + 4 * i) : (f32x4){0.f, 0.f, 0.f, 0.f}; gq[i] = (j < 6) ? *(const f32x4*)(gqn + 16 * j + 4 * i) : (f32x4){0.f, 0.f, 0.f, 0.f}; }
    for (int ku = blockIdx.x; ku < 208; ku += gridDim.x) {
        const int row0 = 64 * ku; const bool samp = row0 >= NPR;
        int key0, Lk; size_t vt0;
        if (!samp) { const int e = row0 >> 8; key0 = row0 & 255; Lk = 256; vt0 = (size_t)e * 8 * 64 * 256; }
        else { const int rr = row0 - NPR, e = rr / 2560; key0 = rr % 2560; Lk = 2560; vt0 = VT_S + (size_t)e * 8 * 64 * 2560; }
        const bool rope = samp && key0 >= 512;
        for (int i = 0; i < 8; ++i) {
            const int kl = 8 * wave + i, row = row0 + kl;
            f32x4 v[4]; float ss = 0.f;
            const float* src = (j < 4) ? kvraw + (size_t)row * 1024 + 128 * h + 16 * j : kr32 + (size_t)row * 32 + 16 * (j & 1);
#pragma unroll
            for (int q = 0; q < 4; ++q) { v[q] = (j < 6) ? *(const f32x4*)(src + 4 * q) : (f32x4){0.f, 0.f, 0.f, 0.f}; ss += (v[q][0] * v[q][0] + v[q][1] * v[q][1]) + (v[q][2] * v[q][2] + v[q][3] * v[q][3]); }
            ss += __shfl_xor(ss, 1); ss += __shfl_xor(ss, 2); ss += __shfl_xor(ss, 4);
            const float rstd = rsqrtf(ss * (1.0f / 96.0f) + 1e-6f);
#pragma unroll
            for (int q = 0; q < 4; ++q) v[q] = v[q] * rstd * gk[q];
            if (rope && j >= 4 && j < 6) {
                const int t = key0 - 512 + kl, pos = (j == 4) ? (t >> 6) : (t & 63);
#pragma unroll
                for (int q = 0; q < 2; ++q)
#pragma unroll
                    for (int e2 = 0; e2 < 4; ++e2) { const float cs = RC[pos * 8 + 4 * q + e2], sn = RC[512 + pos * 8 + 4 * q + e2]; const float x1 = v[q][e2], x2 = v[2 + q][e2]; v[q][e2] = x1 * cs - x2 * sn; v[2 + q][e2] = x1 * sn + x2 * cs; }
            }
            if (j < 6) { bf16_t* kp = Kb + (size_t)row * 768 + 96 * h + 16 * j; *(u32x4*)kp = pack8(v[0], v[1]); *(u32x4*)(kp + 8) = pack8(v[2], v[3]); }
            const float* vs = kvraw + (size_t)row * 1024 + 128 * h + 64 + 8 * j;
            const f32x4 a = *(const f32x4*)vs, b = *(const f32x4*)(vs + 4);
            const u32x4 pk = pack8(a, b);
            LAS bf16_t* vd = Vsm + (64 * h + 8 * j) * 72 + kl;
            vd[0 * 72] = (bf16_t)(pk.x & 0xffffu); vd[1 * 72] = (bf16_t)(pk.x >> 16); vd[2 * 72] = (bf16_t)(pk.y & 0xffffu); vd[3 * 72] = (bf16_t)(pk.y >> 16);
            vd[4 * 72] = (bf16_t)(pk.z & 0xffffu); vd[5 * 72] = (bf16_t)(pk.z >> 16); vd[6 * 72] = (bf16_t)(pk.w & 0xffffu); vd[7 * 72] = (bf16_t)(pk.w >> 16);
        }
        __syncthreads();
#pragma unroll
        for (int it = 0; it < 8; ++it) { const int col = 64 * wave + 8 * it + (lane >> 3), ch = lane & 7;
            const u32x4 d = *(const LAS u32x4*)(Vsm + col * 72 + 8 * ch);
            *(u32x4*)(Vt + vt0 + (size_t)col * Lk + key0 + 8 * ch) = d; }
        __syncthreads();
    }
    const int gw = blockIdx.x * 8 + wave, NGW = gridDim.x * 8;
    for (int r = gw; r < NTOK; r += NGW) {
        f32x4 v[4]; float ss = 0.f;
        const float* src = qraw + (size_t)r * 768 + 96 * h + 16 * (j < 6 ? j : 0);
#pragma unroll
        for (int q = 0; q < 4; ++q) { v[q] = (j < 6) ? *(const f32x4*)(src + 4 * q) : (f32x4){0.f, 0.f, 0.f, 0.f}; ss += (v[q][0] * v[q][0] + v[q][1] * v[q][1]) + (v[q][2] * v[q][2] + v[q][3] * v[q][3]); }
        ss += __shfl_xor(ss, 1); ss += __shfl_xor(ss, 2); ss += __shfl_xor(ss, 4);
        const float rstd = rsqrtf(ss * (1.0f / 96.0f) + 1e-6f) * QSCALE;
#pragma unroll
        for (int q = 0; q < 4; ++q) v[q] = v[q] * rstd * gq[q];
        if (r >= NPR && j >= 4 && j < 6) {
            const int t = (r - NPR) & 2047, pos = (j == 4) ? (t >> 6) : (t & 63);
#pragma unroll
            for (int q = 0; q < 2; ++q)
#pragma unroll
                for (int e2 = 0; e2 < 4; ++e2) { const float cs = RC[pos * 8 + 4 * q + e2], sn = RC[512 + pos * 8 + 4 * q + e2]; const float x1 = v[q][e2], x2 = v[2 + q][e2]; v[q][e2] = x1 * cs - x2 * sn; v[2 + q][e2] = x1 * sn + x2 * cs; }
        }
        if (j < 6) { bf16_t* qp = Qb + (size_t)r * 768 + 96 * h + 16 * j; *(u32x4*)qp = pack8(v[0], v[1]); *(u32x4*)(qp + 8) = pack8(v[2], v[3]); }
    }
}

__device__ __forceinline__ void attn_phase(LAS unsigned char* lds, const bf16_t* Qb, const bf16_t* Kb, const bf16_t* Vt, bf16_t* CAT, int tid, int wave, int lane, int u_lo, int u_hi) {
    const int rg = wave & 3, kp = wave >> 2, l31 = lane & 31, hh = lane >> 5;
    const int pi = 16 * (l31 >> 4) + 8 * ((l31 >> 2) & 1) + 4 * ((l31 >> 3) & 1) + (l31 & 3);
    LAS unsigned char* Ks = lds; LAS unsigned char* Vs = lds + 26624; LAS float* CB = (LAS float*)(lds + 45056);
    int krow[3], kc[3], vrow[2], vc[2];
#pragma unroll
    for (int i = 0; i < 3; ++i) { const int idx = tid + 512 * i; krow[i] = idx / 12; kc[i] = idx % 12; }
#pragma unroll
    for (int i = 0; i < 2; ++i) { const int idx = tid + 512 * i; vrow[i] = idx >> 4; vc[i] = idx & 15; }
    for (int u = u_lo + blockIdx.x; u < u_hi; u += gridDim.x) {
        int h, q0, kvrow0, Lk; size_t vt0;
        if (u < 256) { const int e = u >> 7, qb = u & 15; h = (u >> 4) & 7; q0 = NPR + e * 2048 + qb * 128; kvrow0 = NPR + e * 2560; Lk = 2560; vt0 = VT_S + (size_t)((e * 8 + h) * 64) * 2560; }
        else { const int uu = u - 256, e = uu >> 4, qb = uu & 1; h = (uu >> 1) & 7; q0 = e * 256 + qb * 128; kvrow0 = e * 256; Lk = 256; vt0 = (size_t)((e * 8 + h) * 64) * 256; }
        bf16x8 qreg[6];
        { const bf16_t* qp = Qb + (size_t)(q0 + 32 * rg + l31) * 768 + 96 * h + 8 * hh;
#pragma unroll
          for (int kk = 0; kk < 6; ++kk) qreg[kk] = *(const bf16x8*)(qp + 16 * kk); }
        f32x16 o0, o1;
#pragma unroll
        for (int jj = 0; jj < 16; ++jj) { o0[jj] = 0.f; o1[jj] = 0.f; }
        float m = -1e30f, lsum = 0.f;
        const int nit = Lk >> 7;
        u32x4 kst[3], vst[2];
        const bf16_t* kbase_g = Kb + (size_t)kvrow0 * 768 + 96 * h; const bf16_t* vbase_g = Vt + vt0;
#define ATT_PREFETCH(it) do { _Pragma("unroll") for (int i = 0; i < 3; ++i) kst[i] = *(const u32x4*)(kbase_g + (size_t)(128 * (it) + krow[i]) * 768 + 8 * kc[i]); \
                              _Pragma("unroll") for (int i = 0; i < 2; ++i) vst[i] = *(const u32x4*)(vbase_g + (size_t)vrow[i] * Lk + 128 * (it) + 8 * vc[i]); } while (0)
        ATT_PREFETCH(0);
        for (int it = 0; it < nit; ++it) {
            __syncthreads();
#pragma unroll
            for (int i = 0; i < 3; ++i) *(LAS u32x4*)(Ks + krow[i] * 208 + kc[i] * 16) = kst[i];
#pragma unroll
            for (int i = 0; i < 2; ++i) *(LAS u32x4*)(Vs + vrow[i] * 272 + vc[i] * 16) = vst[i];
            __syncthreads();
            if (it + 1 < nit) ATT_PREFETCH(it + 1);
            for (int kpe = 0; kpe < 2; ++kpe) {
            f32x16 s0, s1;
#pragma unroll
            for (int jj = 0; jj < 16; ++jj) { s0[jj] = 0.f; s1[jj] = 0.f; }
            const LAS unsigned char* kb_l = Ks + (64 * kpe + pi) * 208 + 16 * hh;
#pragma unroll
            for (int kk = 0; kk < 6; ++kk) {
                const bf16x8 a0 = *(const LAS bf16x8*)(kb_l + 32 * kk), a1 = *(const LAS bf16x8*)(kb_l + 32 * 208 + 32 * kk);
                s0 = __builtin_amdgcn_mfma_f32_32x32x16_bf16(a0, qreg[kk], s0, 0, 0, 0);
                s1 = __builtin_amdgcn_mfma_f32_32x32x16_bf16(a1, qreg[kk], s1, 0, 0, 0);
            }
            float mx = fmaxf(s0[0], s1[0]);
#pragma unroll
            for (int jj = 1; jj < 16; ++jj) mx = fmaxf(mx, fmaxf(s0[jj], s1[jj]));
            mx = fmaxf(mx, __shfl_xor(mx, 32));
            const float mn = fmaxf(m, mx), alpha = fexp2(m - mn); m = mn;
            float rs = 0.f;
#pragma unroll
            for (int jj = 0; jj < 16; ++jj) { s0[jj] = fexp2(s0[jj] - mn); s1[jj] = fexp2(s1[jj] - mn); rs += s0[jj] + s1[jj]; }
            lsum = lsum * alpha + rs;
#pragma unroll
            for (int jj = 0; jj < 16; ++jj) { o0[jj] *= alpha; o1[jj] *= alpha; }
            const LAS unsigned char* vb_l = Vs + l31 * 272 + 128 * kpe + 16 * hh;
#pragma unroll
            for (int kb = 0; kb < 4; ++kb) {
                u32x4 pw;
                if (kb < 2) { pw.x = cvt_pk_bf16(s0[8 * kb + 0], s0[8 * kb + 1]); pw.y = cvt_pk_bf16(s0[8 * kb + 2], s0[8 * kb + 3]); pw.z = cvt_pk_bf16(s0[8 * kb + 4], s0[8 * kb + 5]); pw.w = cvt_pk_bf16(s0[8 * kb + 6], s0[8 * kb + 7]); }
                else { const int k2 = kb - 2; pw.x = cvt_pk_bf16(s1[8 * k2 + 0], s1[8 * k2 + 1]); pw.y = cvt_pk_bf16(s1[8 * k2 + 2], s1[8 * k2 + 3]); pw.z = cvt_pk_bf16(s1[8 * k2 + 4], s1[8 * k2 + 5]); pw.w = cvt_pk_bf16(s1[8 * k2 + 6], s1[8 * k2 + 7]); }
                const bf16x8 pb = __builtin_bit_cast(bf16x8, pw);
                const bf16x8 a0 = *(const LAS bf16x8*)(vb_l + 32 * kb), a1 = *(const LAS bf16x8*)(vb_l + 32 * 272 + 32 * kb);
                o0 = __builtin_amdgcn_mfma_f32_32x32x16_bf16(a0, pb, o0, 0, 0, 0);
                o1 = __builtin_amdgcn_mfma_f32_32x32x16_bf16(a1, pb, o1, 0, 0, 0);
            }
            }
        }
#undef ATT_PREFETCH
        if (kp == 0) {
#pragma unroll
            for (int jj = 0; jj < 16; ++jj) { CB[(rg * 34 + jj) * 64 + lane] = o0[jj]; CB[(rg * 34 + 16 + jj) * 64 + lane] = o1[jj]; }
            CB[(rg * 34 + 32) * 64 + lane] = m; CB[(rg * 34 + 33) * 64 + lane] = lsum;
        }
        __syncthreads();
        if (kp == 1) {
            const float m1 = CB[(rg * 34 + 32) * 64 + lane], l1 = CB[(rg * 34 + 33) * 64 + lane];
            const float mt = m, a0 = 1.0f, a1 = 0.0f * m1;
            float lt = lsum * a0 + 0.0f * l1; lt += __shfl_xor(lt, 32);
            const float inv = 1.0f / lt;
            bf16_t* op = CAT + (size_t)(q0 + 32 * rg + l31) * 1024 + 64 * h + 4 * hh;
#pragma unroll
            for (int g4 = 0; g4 < 4; ++g4) {
                u32x2 w0, w1; float t0[4], t1[4];
#pragma unroll
                for (int e2 = 0; e2 < 4; ++e2) { const int jj = 4 * g4 + e2; t0[e2] = (o0[jj] * a0 + CB[(rg * 34 + jj) * 64 + lane] * a1) * inv; t1[e2] = (o1[jj] * a0 + CB[(rg * 34 + 16 + jj) * 64 + lane] * a1) * inv; }
                w0.x = cvt_pk_bf16(t0[0], t0[1]); w0.y = cvt_pk_bf16(t0[2], t0[3]); w1.x = cvt_pk_bf16(t1[0], t1[1]); w1.y = cvt_pk_bf16(t1[2], t1[3]);
                *(u32x2*)(op + 8 * g4) = w0; *(u32x2*)(op + 32 + 8 * g4) = w1;
            }
        }
        __syncthreads();
    }
}


__device__ __forceinline__ void attn_simple(const bf16_t* Qb, const bf16_t* Kb, const bf16_t* Vt, bf16_t* CAT, int tid, int tok_lo, int tok_hi) {
    const int n = tok_hi * 8, stride = gridDim.x * 512;
    for (int idx = tok_lo * 8 + blockIdx.x * 512 + tid; idx < n; idx += stride) {
        const int tok = idx >> 3, h = idx & 7;
        int kvrow0, Lk; size_t vt0;
        if (tok < NPR) { const int e = tok >> 8; kvrow0 = e * 256; Lk = 256; vt0 = (size_t)((e * 8 + h) * 64) * 256; }
        else { const int e = (tok - NPR) >> 11; kvrow0 = NPR + e * 2560; Lk = 2560; vt0 = VT_S + (size_t)((e * 8 + h) * 64) * 2560; }
        unsigned q[48];
#pragma unroll
        for (int d = 0; d < 48; ++d) q[d] = *(const unsigned*)(Qb + (size_t)tok * 768 + 96 * h + 2 * d);
#pragma unroll 1
        for (int dc = 0; dc < 4; ++dc) {
        float o[16];
#pragma unroll
        for (int d = 0; d < 16; ++d) o[d] = 0.f;
        float m = -1e30f, l = 0.f;
        const bf16_t* vp = Vt + vt0 + (size_t)(16 * dc) * Lk;
#pragma unroll 1
        for (int key = 0; key < Lk; ++key) {
            const bf16_t* kp = Kb + (size_t)(kvrow0 + key) * 768 + 96 * h;
            float sdot = 0.f;
#pragma unroll
            for (int d = 0; d < 48; ++d) { const unsigned kw = *(const unsigned*)(kp + 2 * d); sdot = fmaf(__uint_as_float(q[d] << 16), __uint_as_float(kw << 16), sdot); sdot = fmaf(__uint_as_float(q[d] & 0xffff0000u), __uint_as_float(kw & 0xffff0000u), sdot); }
            const float mn = fmaxf(m, sdot), alpha = fexp2(m - mn), p = fexp2(sdot - mn); m = mn;
            l = l * alpha + p;
#pragma unroll
            for (int d = 0; d < 16; ++d) o[d] = o[d] * alpha + p * bf2f(vp[(size_t)d * Lk + key]);
        }
        const float inv = 1.0f / l;
#pragma unroll
        for (int d = 0; d < 16; d += 2) *(unsigned*)(CAT + (size_t)tok * 1024 + 64 * h + 16 * dc + d) = cvt_pk_bf16(o[d] * inv, o[d + 1] * inv);
        }
    }
}

__device__ __forceinline__ void conv_phase(const bf16_t* ZC, const bf16_t* GB, const float* cw, bf16_t* A, int tid) {
    const int n = NTOK * 128, stride = gridDim.x * 512;
    for (int idx = blockIdx.x * 512 + tid; idx < n; idx += stride) {
        const int tok = idx >> 7, c0 = (idx & 127) * 8;
        const int p = tok < NPR ? (tok & 255) : ((tok - NPR) & 2047), L = tok < NPR ? 256 : 2048;
        const u32x4 zero = {0u, 0u, 0u, 0u};
        const u32x4 zc = *(const u32x4*)(ZC + (size_t)tok * 1024 + c0);
        const u32x4 zp = (p > 0) ? *(const u32x4*)(ZC + (size_t)(tok - 1) * 1024 + c0) : zero;
        const u32x4 zn = (p < L - 1) ? *(const u32x4*)(ZC + (size_t)(tok + 1) * 1024 + c0) : zero;
        const u32x4 gb = *(const u32x4*)(GB + (size_t)tok * 1024 + c0);
        float w[24];
#pragma unroll
        for (int q = 0; q < 6; ++q) { const f32x4 t = *(const f32x4*)(cw + (size_t)c0 * 3 + 4 * q); w[4 * q] = t[0]; w[4 * q + 1] = t[1]; w[4 * q + 2] = t[2]; w[4 * q + 3] = t[3]; }
        float o[8];
#pragma unroll
        for (int e = 0; e < 8; ++e) {
            const unsigned wp = zp[e >> 1], wc_ = zc[e >> 1], wn = zn[e >> 1], wg = gb[e >> 1];
            const float fp = (e & 1) ? __uint_as_float(wp & 0xffff0000u) : __uint_as_float(wp << 16);
            const float fc = (e & 1) ? __uint_as_float(wc_ & 0xffff0000u) : __uint_as_float(wc_ << 16);
            const float fn = (e & 1) ? __uint_as_float(wn & 0xffff0000u) : __uint_as_float(wn << 16);
            const float fg = (e & 1) ? __uint_as_float(wg & 0xffff0000u) : __uint_as_float(wg << 16);
            o[e] = fg * (w[3 * e] * fp + w[3 * e + 1] * fc + w[3 * e + 2] * fn);
        }
        u32x4 r; r.x = cvt_pk_bf16(o[0], o[1]); r.y = cvt_pk_bf16(o[2], o[3]); r.z = cvt_pk_bf16(o[4], o[5]); r.w = cvt_pk_bf16(o[6], o[7]);
        *(u32x4*)(A + (size_t)tok * 1024 + c0) = r;
    }
}

#ifndef MK_KINDS
#define MK_KINDS 0xFFFF
#endif
#define HAS(k) (((MK_KINDS) >> (k)) & 1)
#ifndef ABL_ULO
#define ABL_ULO 0
#define ABL_UHI 768
#define ABL_TLO 0
#define ABL_THI 0
#endif
struct Args { const float* in[35]; float* out; unsigned char* ws; int ph_lo, ph_hi; };

__global__ void __launch_bounds__(512, 2) mk_fwd(Args args) {
    extern __shared__ __attribute__((aligned(16))) unsigned char lds_raw[];
    LAS unsigned char* lds = (LAS unsigned char*)lds_raw;
    cg::grid_group grid = cg::this_grid();
    const int G = gridDim.x, bid = blockIdx.x;
    const float* const* in = args.in;
    unsigned char* ws = args.ws; float* out = args.out; float* X = out;
    float* mods = (float*)(ws + WS_MODS);
    bf16_t* H = (bf16_t*)(ws + WS_H); bf16_t* ACT = (bf16_t*)(ws + WS_ACT);
    float* PROJ = (float*)(ws + WS_PROJ); float* KVRAW = (float*)(ws + WS_KVRAW); float* QRAW = (float*)(ws + WS_QRAW);
    bf16_t* CQN = (bf16_t*)(ws + WS_CQN); bf16_t* CKVN = (bf16_t*)(ws + WS_CKVN); float* KR32 = (float*)(ws + WS_KR32);
    float* Z = (float*)(ws + WS_Z); bf16_t* ZB = (bf16_t*)(ws + WS_ZB);
    bf16_t* KB = (bf16_t*)(ws + WS_KB); bf16_t* VT = (bf16_t*)(ws + WS_VT); bf16_t* QB = (bf16_t*)(ws + WS_QB);
    bf16_t* ZC = (bf16_t*)(ws + WS_ZC); bf16_t* GBF = (bf16_t*)(ws + WS_GB);

    for (int ph = args.ph_lo; ph < args.ph_hi; ++ph) {
        int tid = threadIdx.x; asm volatile("" : "+v"(tid));
        const int lane = tid & 63, wave = __builtin_amdgcn_readfirstlane(tid >> 6);
        int kind, l = 0, sub = 0;
        if (ph == 0) kind = 0;
        else if (ph <= 13) { l = 0; const int q = ph - 1;
            kind = (q == 0 || q == 3 || q == 10) ? 1 : (q == 1 || q == 11) ? 2 : (q == 2 || q == 9 || q == 12) ? 3 : (q == 4) ? 4 : (q == 5) ? 5 : (q == 6) ? 6 : (q == 7) ? 7 : 8;
            sub = (q <= 2) ? 0 : (q <= 9) ? 1 : 2; }
        else { l = 1; const int q = ph - 14;
            kind = (q == 0 || q == 3 || q == 7) ? 1 : (q == 1 || q == 8) ? 2 : (q == 2 || q == 6 || q == 9) ? 3 : (q == 4) ? 9 : 10;
            sub = (q <= 2) ? 0 : (q <= 6) ? 1 : 2; }
        const float* mods_l = mods + (size_t)l * 3 * 9216;

        if (HAS(0) && kind == 0) phase0(lds, in, ws, tid, wave, lane);
        else if (HAS(1) && kind == 1) {
            const bool first = (ph == 1);
            normmod_phase(first ? in[0] : X, first ? in[1] : X + (size_t)NPR * 1024, first ? X : nullptr, H, in[10] + (size_t)(l * 3 + sub) * 1024, mods_l, sub, wave, lane);
        } else if (HAS(2) && kind == 2) {
            const int lf = l * 2 + (sub == 2 ? 1 : 0);
            pg8::Gemm g{H, (const bf16_t*)(ws + WS_WGU) + (size_t)lf * WGU_EL, NTOK, 5632, 1024}; pg8::StaticOrder S; S.init(NTOK, 5632, G, bid);
            EpiSwiGLU E{ACT};
            pg8::gemm_phase<EpiSwiGLU, pg8::StaticOrder, true, true>(lds, g, S, E, tid);
        } else if (HAS(3) && kind == 3) {
            pg8::Gemm g; float gs; int gi;
            if (sub == 1) { g = pg8::Gemm{H, (const bf16_t*)(ws + (l == 0 ? WS_WOUT : WS_WCOUT)), NTOK, 1024, 1024}; gs = 1.0f; gi = 5; }
            else { const int lf = l * 2 + (sub == 2 ? 1 : 0); g = pg8::Gemm{ACT, (const bf16_t*)(ws + WS_WD) + (size_t)lf * WD_EL, NTOK, 1024, 2816}; gs = 0.5f; gi = (sub == 0) ? 2 : 8; }
            pg8::StaticOrder S; S.init(NTOK, 1024, G, bid);
            EpiResid E{X, mods_l + gi * 1024, gs};
            pg8::gemm_phase<EpiResid, pg8::StaticOrder, true, true>(lds, g, S, E, tid);
        } else if (HAS(4) && (kind == 4 || kind == 6)) {
            const int ng = (kind == 4) ? 1 : 2;
            for (int gi = 0; gi < ng; ++gi) {
                pg8::Gemm g; EpiF32 E; int coff;
                if (kind == 4) { g = pg8::Gemm{H, (const bf16_t*)(ws + WS_WIN), NTOK, 1280, 1024}; E = EpiF32{PROJ, 1280}; coff = 0; }
                else if (gi == 0) { g = pg8::Gemm{CQN, (const bf16_t*)(ws + WS_WUQ), NTOK, 768, 384}; E = EpiF32{QRAW, 768}; coff = 0; }
                else { g = pg8::Gemm{CKVN, (const bf16_t*)(ws + WS_WUKV), NKV, 1024, 256}; E = EpiF32{KVRAW, 1024}; coff = 112; }
                pg8::StaticOrder S; S.init(g.M, g.N, G, (bid + coff) % G);
                pg8::gemm_phase<EpiF32, pg8::StaticOrder, true, true>(lds, g, S, E, tid);
            }
            if (HAS(6) && kind == 6) {
                pg8::Gemm g{ZB, (const bf16_t*)(ws + WS_WGLU), NTOK, 512, 512}; pg8::StaticOrder S; S.init(NTOK, 512, G, (bid + 160) % G);
                EpiGLU E{Z, in[30], H + 512};
                pg8::gemm_phase<EpiGLU, pg8::StaticOrder, true, true>(lds, g, S, E, tid);
            }
        } else if (HAS(5) && kind == 5) {
            post1_rows(in, PROJ, CQN, CKVN, KR32, out, wave, lane);
            s5_phase(lds, in, PROJ, Z, ZB, out, wave, lane);
        } else if (HAS(7) && kind == 7) {
            post2_phase(lds, KVRAW, KR32, QRAW, in[20], in[19], KB, VT, QB, tid, wave, lane);
        } else if (HAS(8) && kind == 8) {
            attn_phase(lds, QB, KB, VT, H, tid, wave, lane, ABL_ULO, ABL_UHI);
            attn_simple(QB, KB, VT, H, tid, ABL_TLO, ABL_THI);
        } else if (HAS(9) && kind == 9) {
            pg8::Gemm g{H, (const bf16_t*)(ws + WS_WCIN), NTOK, 3072, 1024}; pg8::StaticOrder S; S.init(NTOK, 3072, G, bid);
            EpiConvIn E{ZC, GBF};
            pg8::gemm_phase<EpiConvIn, pg8::StaticOrder, true, true>(lds, g, S, E, tid);
        } else if (HAS(10)) {
            conv_phase(ZC, GBF, in[33], H, tid);
        }
        if (ph + 1 < args.ph_hi) grid.sync();
    }
}

extern "C" void kernel_launch(void* const* d_in, const int* in_sizes, int n_in, void* d_out, int out_size, void* d_ws, size_t ws_size, hipStream_t stream) {
    static int grid = 0;
    if (grid == 0) {
        int dev = 0, cus = 0, per_cu = 0;
        if (n_in != 35 || ws_size < (size_t)280 * MiB) { fprintf(stderr, "kernel_launch: unexpected n_in %d / ws %zu\n", n_in, ws_size); grid = -1; return; }
        hipGetDevice(&dev); hipDeviceGetAttribute(&cus, hipDeviceAttributeMultiprocessorCount, dev);
        if (hipFuncSetAttribute((const void*)mk_fwd, hipFuncAttributeMaxDynamicSharedMemorySize, LDS_BYTES) != hipSuccess) { fprintf(stderr, "kernel_launch: hipFuncSetAttribute failed\n"); grid = -1; return; }
        if (hipOccupancyMaxActiveBlocksPerMultiprocessor(&per_cu, (const void*)mk_fwd, 512, LDS_BYTES) != hipSuccess || per_cu < 1) { fprintf(stderr, "kernel_launch: occupancy query says %d\n", per_cu); per_cu = 1; }
        (void)hipGetLastError();
        grid = cus * 1;
        if (grid > 256) grid = 256;
    }
    if (grid < 0) return;
    Args a{};
    for (int i = 0; i < 35; ++i) a.in[i] = (const float*)d_in[i];
    a.out = (float*)d_out; a.ws = (unsigned char*)d_ws;
#if MK_MULTI
    for (int ph = 0; ph < NPHASE; ++ph) { a.ph_lo = ph; a.ph_hi = ph + 1; hipLaunchKernelGGL(mk_fwd, dim3(grid), dim3(512), LDS_BYTES, stream, a); }
#else
    a.ph_lo = 0; a.ph_hi = NPHASE;
    void* kargs[] = {&a};
    hipError_t e = hipLaunchCooperativeKernel((const void*)mk_fwd, dim3(grid), dim3(512), kargs, LDS_BYTES, stream);
    if (e != hipSuccess) fprintf(stderr, "kernel_launch: cooperative launch failed: %s (grid %d)\n", hipGetErrorString(e), grid);
#endif
}
```

```cpp
#include <hip/hip_runtime.h>
#include <hip/hip_cooperative_groups.h>
#include <cstdio>
#include <cstdint>
namespace cg = cooperative_groups;
#ifndef MK_MULTI
#define MK_MULTI 0
#endif
namespace pg8 {
#define PG8_LAS __attribute__((address_space(3)))
typedef unsigned short bf16_t;
typedef short bf16x8 __attribute__((ext_vector_type(8)));
typedef float f32x4 __attribute__((ext_vector_type(4)));
typedef unsigned u32x4 __attribute__((ext_vector_type(4)));
constexpr int BM = 256, BK = 64, HALF = 128, HTB = HALF * BK * 2  , STAGE_BYTES = 8 * HTB, NXCD = 8, WGM = 8;

__host__ __device__ __forceinline__ int lds_byte(int r, int c) { const int st = (r >> 4) * 2 + (c >> 5), rr = r & 15, cc = c & 31, ob = rr * 64 + cc * 2; return st * 1024 + (ob ^ (((ob >> 9) & 1) << 5)); }
__host__ __device__ __forceinline__ void stage_rc(int b, int& R, int& C) { const int st = b / 1024, sb = b % 1024, swz = sb ^ (((sb >> 9) & 1) << 5); R = (st >> 1) * 16 + swz / 64; C = (st & 1) * 32 + (swz % 64) / 2; }
__host__ __device__ __forceinline__ int perm32(int rho) { const int n = rho >> 4, i = rho & 15; return 8 * (i >> 2) + 4 * n + (i & 3); }

struct Unit { int pm, pn; };
struct Gemm { const bf16_t* A; const bf16_t* Bt; int M, N, K; };

struct StaticOrder {
    int nM, nN, nwg, G, c;
    __host__ __device__ void init(int M, int N, int G_, int c_) { nM = M / BM; nN = N / BM; nwg = nM * nN; G = G_; c = c_; }
    __host__ __device__ bool next(int i, Unit& u) const {
        const long L = (long)i * G + c; if (L >= nwg) return false;
        int wgid = (int)L; { const int q = nwg / NXCD, r = nwg % NXCD, xcd = wgid % NXCD, off = wgid / NXCD; wgid = (xcd < r ? xcd * (q + 1) : r * (q + 1) + (xcd - r) * q) + off; }
        const int nig = WGM * nN, gid = wgid / nig, fm = gid * WGM, gsz = (nM - fm) < WGM ? (nM - fm) : WGM;
        u.pm = fm + ((wgid % nig) % gsz); u.pn = (wgid % nig) / gsz; return true;
    }
    __device__ __forceinline__ void a_ready(const Unit&) const {}
    __device__ __forceinline__ void done(const Unit&) const {}
};

__device__ __forceinline__ unsigned cvt_pk_bf16(float lo, float hi) { unsigned r; asm volatile("v_cvt_pk_bf16_f32 %0, %1, %2" : "=v"(r) : "v"(lo), "v"(hi)); return r; }
typedef float f32x2 __attribute__((ext_vector_type(2)));
template <class Epi, class Sched, bool ALIGN_EPI = false, bool SP2 = false>
__device__ __forceinline__ void gemm_phase(PG8_LAS unsigned char* lds, const Gemm g, const Sched& S, const Epi& E, int tid_in) {
    const int tid = tid_in, wid = __builtin_amdgcn_readfirstlane(tid >> 6), lane = tid & 63, wr = wid >> 2, wc = wid & 3, fr = lane & 15, fq = lane >> 4;
    const int K = g.K, nt = K / BK;
    unsigned voffA[2], voffB[2];
#pragma unroll
    for (int i = 0; i < 2; ++i) { int R, C; stage_rc(tid * 16 + i * 8192, R, C); const int Rb = Epi::PERM ? ((R & ~31) + perm32(R & 31)) : R;
        voffA[i] = (unsigned)(R * K + C) * 2u; voffB[i] = (unsigned)(Rb * K + C) * 2u; }
    const size_t kstep = (size_t)(BK * 2);
    const size_t hstep = (size_t)HALF * K * 2;
    const size_t tstep = 2 * hstep;
    const unsigned ldsw = (unsigned)wid * 1024u;
    const int aoff = lds_byte(wr * 64 + fr, fq * 8), boff = lds_byte(wc * 32 + fr, fq * 8);
#define PG8_SA(b, h) (((b) * 2 + (h)) * HTB)
#define PG8_SB(b, h) ((4 + (b) * 2 + (h)) * HTB)
#define PG8_STAGE(bufoff, gbase, voff) do { _Pragma("unroll") for (int _i = 0; _i < 2; ++_i) \
        __builtin_amdgcn_global_load_lds((const unsigned*)((const char*)(gbase) + (voff)[_i]), (PG8_LAS unsigned*)(lds + (bufoff) + ldsw + _i * 8192), 16, 0, 0); } while (0)
#define PG8_LDA(dst, b, h) do { _Pragma("unroll") for (int m = 0; m < 4; ++m) _Pragma("unroll") for (int k = 0; k < 2; ++k) dst[m][k] = *(const PG8_LAS bf16x8*)(lds + PG8_SA(b, h) + aoff + m * 2048 + k * 1024); } while (0)
#define PG8_LDB(dst, b, h) do { _Pragma("unroll") for (int n = 0; n < 2; ++n) _Pragma("unroll") for (int k = 0; k < 2; ++k) dst[n][k] = *(const PG8_LAS bf16x8*)(lds + PG8_SB(b, h) + boff + n * 2048 + k * 1024); } while (0)
#define PG8_MMA(ai, bj, At, Bt) do { __builtin_amdgcn_s_setprio(1); _Pragma("unroll") for (int m = 0; m < 4; ++m) _Pragma("unroll") for (int n = 0; n < 2; ++n) _Pragma("unroll") for (int k = 0; k < 2; ++k) \
        acc[ai][bj][m][n] = __builtin_amdgcn_mfma_f32_16x16x32_bf16(Bt[n][k], At[m][k], acc[ai][bj][m][n], 0, 0, 0); __builtin_amdgcn_s_setprio(0); } while (0)
#define PG8_WAIT_V(n) asm volatile("s_waitcnt vmcnt(" #n ")" ::: "memory")
#define PG8_WAIT_L(n) asm volatile("s_waitcnt lgkmcnt(" #n ")" ::: "memory")
#define PG8_BAR __builtin_amdgcn_s_barrier()
#define PG8_SCHED __builtin_amdgcn_sched_barrier(0)
    Unit cur, nxt; int ui = 0;
    if (!S.next(0, cur)) return;
    f32x4 acc[2][2][4][2];
#pragma unroll
    for (int a = 0; a < 2; ++a)
#pragma unroll
        for (int b = 0; b < 2; ++b)
#pragma unroll
            for (int m = 0; m < 4; ++m)
#pragma unroll
                for (int n = 0; n < 2; ++n) acc[a][b][m][n] = (f32x4){0.f, 0.f, 0.f, 0.f};
    bf16x8 At[4][2], B0[2][2], B1[2][2];
    const char* cA = (const char*)g.A + (size_t)cur.pm * tstep; const char* cB = (const char*)g.Bt + (size_t)cur.pn * tstep;
    S.a_ready(cur);
    if constexpr (SP2) {
        PG8_STAGE(PG8_SB(0, 0), cB, voffB); PG8_STAGE(PG8_SB(0, 1), cB + hstep, voffB); PG8_STAGE(PG8_SA(0, 0), cA, voffA); PG8_STAGE(PG8_SA(0, 1), cA + hstep, voffA);
        if (wr == 1) PG8_BAR;
        PG8_WAIT_V(2); PG8_BAR;
        PG8_STAGE(PG8_SB(1, 0), cB + kstep, voffB); PG8_STAGE(PG8_SA(1, 0), cA + kstep, voffA); PG8_STAGE(PG8_SB(1, 1), cB + hstep + kstep, voffB);
        PG8_WAIT_V(6); PG8_BAR;
    } else {
        PG8_STAGE(PG8_SB(0, 0), cB, voffB); PG8_STAGE(PG8_SA(0, 0), cA, voffA); PG8_STAGE(PG8_SB(0, 1), cB + hstep, voffB); PG8_STAGE(PG8_SA(0, 1), cA + hstep, voffA);
        if (wr == 1) PG8_BAR;
        PG8_WAIT_V(4); PG8_BAR;
        PG8_STAGE(PG8_SB(1, 0), cB + kstep, voffB); PG8_STAGE(PG8_SA(1, 0), cA + kstep, voffA); PG8_STAGE(PG8_SB(1, 1), cB + hstep + kstep, voffB);
        PG8_WAIT_V(6); PG8_BAR;
    }
    for (;;) {
        const bool has_next = S.next(ui + 1, nxt);
        const char* nA = has_next ? (const char*)g.A + (size_t)nxt.pm * tstep : cA; const char* nB = has_next ? (const char*)g.Bt + (size_t)nxt.pn * tstep : cB;
        for (int t = 0; t < nt; t += 2) {
            const bool last = (t == nt - 2);
            const char* a1 = cA + (size_t)(t + 1) * kstep;
            const char* a2 = last ? nA : cA + (size_t)(t + 2) * kstep; const char* b2 = last ? nB : cB + (size_t)(t + 2) * kstep;
            const char* a3 = a2 + kstep; const char* b3 = b2 + kstep;
            if (last && has_next) S.a_ready(nxt);
            if constexpr (SP2) {
            PG8_LDB(B0, 0, 0); PG8_LDB(B1, 0, 1); PG8_SCHED; PG8_LDA(At, 0, 0); PG8_STAGE(PG8_SA(1, 1), a1 + hstep, voffA);
            PG8_WAIT_V(8); PG8_WAIT_L(0); PG8_BAR; PG8_MMA(0, 0, At, B0); PG8_MMA(0, 1, At, B1); PG8_BAR; PG8_SCHED;
            PG8_LDA(At, 0, 1); PG8_STAGE(PG8_SB(0, 0), b2, voffB); PG8_STAGE(PG8_SB(0, 1), b2 + hstep, voffB); PG8_STAGE(PG8_SA(0, 0), a2, voffA);
            PG8_WAIT_V(8); PG8_WAIT_L(0); PG8_BAR; PG8_MMA(1, 0, At, B0); PG8_MMA(1, 1, At, B1); PG8_BAR; PG8_SCHED;
            PG8_LDB(B0, 1, 0); PG8_LDB(B1, 1, 1); PG8_SCHED; PG8_LDA(At, 1, 0); PG8_STAGE(PG8_SA(0, 1), a2 + hstep, voffA);
            PG8_WAIT_V(8); PG8_WAIT_L(0); PG8_BAR; PG8_MMA(0, 0, At, B0); PG8_MMA(0, 1, At, B1); PG8_BAR; PG8_SCHED;
            PG8_LDA(At, 1, 1); PG8_STAGE(PG8_SB(1, 0), b3, voffB); PG8_STAGE(PG8_SB(1, 1), b3 + hstep, voffB); PG8_STAGE(PG8_SA(1, 0), a3, voffA);
            PG8_WAIT_V(8); PG8_WAIT_L(0); PG8_BAR; PG8_MMA(1, 0, At, B0); PG8_MMA(1, 1, At, B1); PG8_BAR; PG8_SCHED;
            } else {
            PG8_LDB(B0, 0, 0); PG8_SCHED; PG8_LDA(At, 0, 0); PG8_STAGE(PG8_SA(1, 1), a1 + hstep, voffA);
            PG8_WAIT_L(8); PG8_BAR; PG8_WAIT_L(0); PG8_MMA(0, 0, At, B0); PG8_BAR; PG8_SCHED;
            PG8_LDB(B1, 0, 1); PG8_STAGE(PG8_SB(0, 0), b2, voffB);
            PG8_BAR; PG8_WAIT_L(0); PG8_MMA(0, 1, At, B1); PG8_BAR;
            PG8_LDA(At, 0, 1); PG8_STAGE(PG8_SA(0, 0), a2, voffA);
            PG8_BAR; PG8_WAIT_L(0); PG8_MMA(1, 0, At, B0); PG8_BAR; PG8_SCHED;
            PG8_STAGE(PG8_SB(0, 1), b2 + hstep, voffB);
            PG8_WAIT_V(6); PG8_BAR; PG8_MMA(1, 1, At, B1); PG8_BAR;
            PG8_LDB(B0, 1, 0); PG8_SCHED; PG8_LDA(At, 1, 0); PG8_STAGE(PG8_SA(0, 1), a2 + hstep, voffA);
            PG8_WAIT_L(8); PG8_BAR; PG8_WAIT_L(0); PG8_MMA(0, 0, At, B0); PG8_BAR; PG8_SCHED;
            PG8_LDB(B1, 1, 1); PG8_STAGE(PG8_SB(1, 0), b3, voffB);
            PG8_BAR; PG8_WAIT_L(0); PG8_MMA(0, 1, At, B1); PG8_BAR;
            PG8_LDA(At, 1, 1); PG8_STAGE(PG8_SA(1, 0), a3, voffA);
            PG8_BAR; PG8_WAIT_L(0); PG8_MMA(1, 0, At, B0); PG8_BAR; PG8_SCHED;
            PG8_STAGE(PG8_SB(1, 1), b3 + hstep, voffB);
            PG8_WAIT_V(6); PG8_BAR; PG8_MMA(1, 1, At, B1); PG8_BAR;
            }
        }
        if constexpr (ALIGN_EPI) { if (wr == 0) PG8_BAR; }
        if constexpr (!Epi::AFTER_DRAIN) { E(acc, cur, wr, wc, fr, fq); S.done(cur); }
        if (!has_next) break;
#pragma unroll
        for (int a = 0; a < 2; ++a)
#pragma unroll
            for (int b = 0; b < 2; ++b)
#pragma unroll
                for (int m = 0; m < 4; ++m)
#pragma unroll
                    for (int n = 0; n < 2; ++n) acc[a][b][m][n] = (f32x4){0.f, 0.f, 0.f, 0.f};
        cur = nxt; cA = nA; cB = nB; ++ui;
        if constexpr (ALIGN_EPI) { if (wr == 1) PG8_BAR; }
    }
    PG8_WAIT_V(0);
    if constexpr (!ALIGN_EPI) { if (wr == 0) PG8_BAR; }
    PG8_BAR;
    if constexpr (Epi::AFTER_DRAIN) { E.fused(acc, cur, wr, wc, fr, fq, lds, wid, lane); S.done(cur); }
#undef PG8_SA
#undef PG8_SB
#undef PG8_STAGE
#undef PG8_LDA
#undef PG8_LDB
#undef PG8_MMA
#undef PG8_WAIT_V
#undef PG8_WAIT_L
#undef PG8_BAR
#undef PG8_SCHED
}
}

using pg8::bf16_t; using pg8::bf16x8; using pg8::f32x4; using pg8::u32x4; using pg8::cvt_pk_bf16; using pg8::Unit;
#define LAS __attribute__((address_space(3)))
typedef float f32x16 __attribute__((ext_vector_type(16)));
typedef unsigned u32x2 __attribute__((ext_vector_type(2)));

constexpr int NTOK = 12288, NPR = 8192, NKV = 13312;
constexpr size_t MiB = 1u << 20;
constexpr size_t WS_MODS = 65536;
constexpr size_t WS_WGU = 2 * MiB, WGU_EL = (size_t)5632 * 1024;
constexpr size_t WS_WD = 46 * MiB, WD_EL = (size_t)1024 * 2816;
constexpr size_t WS_WIN = 68 * MiB, WS_WUQ = 70 * MiB + MiB / 2, WS_WUKV = 71 * MiB + MiB / 4, WS_WGLU = 71 * MiB + 3 * MiB / 4, WS_WOUT = 72 * MiB + MiB / 2,
                 WS_WCIN = 74 * MiB + MiB / 2, WS_WCOUT = 80 * MiB + MiB / 2;
constexpr size_t WS_H = 84 * MiB, WS_BIG = 108 * MiB;
constexpr size_t WS_ACT = WS_BIG, WS_PROJ = WS_BIG, WS_KVRAW = WS_BIG, WS_CQN = WS_BIG + 60 * MiB, WS_CKVN = WS_BIG + 69 * MiB, WS_VT = WS_BIG + 60 * MiB,
                 WS_KR32 = WS_BIG + 76 * MiB, WS_Z = WS_BIG + 78 * MiB, WS_QB = WS_BIG + 78 * MiB, WS_ZB = WS_BIG + 102 * MiB, WS_QRAW = WS_BIG + 114 * MiB, WS_KB = WS_BIG + 150 * MiB;
constexpr size_t WS_ZC = WS_BIG, WS_GB = WS_BIG + 24 * MiB;
constexpr size_t VT_S = (size_t)32 * 8 * 64 * 256;
constexpr int OUT_CKV = 12582912, OUT_KR = 14680064, OUT_SRE = 14942208, OUT_SIM = 15073280;
constexpr int LDS_BYTES = 147456;
constexpr int NPHASE = 24;

#define LDS_WAIT() asm volatile("s_waitcnt lgkmcnt(0)" ::: "memory")
__device__ __forceinline__ float wave_sum(float v) {
#pragma unroll
    for (int o = 1; o < 64; o <<= 1) v += __shfl_xor(v, o);
    return v;
}
__device__ __forceinline__ float bf2f(unsigned short b) { return __uint_as_float((unsigned)b << 16); }
__device__ __forceinline__ u32x4 pack8(f32x4 a, f32x4 b) { u32x4 w; w.x = cvt_pk_bf16(a[0], a[1]); w.y = cvt_pk_bf16(a[2], a[3]); w.z = cvt_pk_bf16(b[0], b[1]); w.w = cvt_pk_bf16(b[2], b[3]); return w; }
__device__ __forceinline__ bf16x8 pack8v(f32x4 a, f32x4 b) { u32x4 w = pack8(a, b); return __builtin_bit_cast(bf16x8, w); }
__device__ __forceinline__ float fexp2(float x) { return __builtin_amdgcn_exp2f(x); }
__device__ __forceinline__ float sigmoidf_(float v) { return __builtin_amdgcn_rcpf(1.0f + fexp2(-1.44269504f * v)); }
__device__ __forceinline__ float gelu_tanh(float v) { const float u = 0.7978845608f * (v + 0.044715f * v * v * v); const float t = 1.0f - 2.0f * __builtin_amdgcn_rcpf(1.0f + fexp2(2.88539008f * u)); return 0.5f * v * (1.0f + t); }
__device__ __forceinline__ void sincos_acc(float x, float& s, float& c) {
    const float n = rintf(x * 0.636619772f);
    float r = fmaf(-n, 1.5707855225e+00f, x); r = fmaf(-n, 1.0804334124e-05f, r);
    const float r2 = r * r;
    const float sp = r + r * r2 * (-1.6666667e-1f + r2 * (8.3333333e-3f + r2 * (-1.9841270e-4f + r2 * 2.7557319e-6f)));
    const float cp = 1.f + r2 * (-0.5f + r2 * (4.1666667e-2f + r2 * (-1.3888889e-3f + r2 * (2.4801587e-5f + r2 * (-2.7557319e-7f)))));
    const int q = ((int)n) & 3;
    s = (q == 0) ? sp : (q == 1) ? cp : (q == 2) ? -sp : -cp;
    c = (q == 0) ? cp : (q == 1) ? -sp : (q == 2) ? -cp : sp;
}
__device__ __forceinline__ int cond_of_row(int row) { return row < NPR ? 0 : 1 + ((row - NPR) >> 11); }

struct EpiSwiGLU {
    static constexpr bool PERM = true, AFTER_DRAIN = false;
    bf16_t* O;
    __device__ __forceinline__ void operator()(const f32x4 (&acc)[2][2][4][2], const Unit& u, int wr, int wc, int fr, int fq) const {
        const int row0 = u.pm * 256 + wr * 64 + fr, col0 = u.pn * 128 + wc * 32 + 8 * fq;
#pragma unroll
        for (int ai = 0; ai < 2; ++ai)
#pragma unroll
            for (int m = 0; m < 4; ++m) {
                f32x4 v[2];
#pragma unroll
                for (int n = 0; n < 2; ++n)
#pragma unroll
                    for (int j = 0; j < 4; ++j) { const float g = acc[ai][0][m][n][j]; v[n][j] = g * sigmoidf_(g) * acc[ai][1][m][n][j]; }
                *(u32x4*)(O + (size_t)(row0 + ai * 128 + m * 16) * 2816 + col0) = pack8(v[0], v[1]);
            }
    }
};
struct EpiResid {
    static constexpr bool PERM = false, AFTER_DRAIN = false;
    float* X; const float* gate; float gs;
    __device__ __forceinline__ void operator()(const f32x4 (&acc)[2][2][4][2], const Unit& u, int wr, int wc, int fr, int fq) const {
        const int cnd = u.pm < 32 ? 0 : 1 + ((u.pm - 32) >> 3);
        const float* gp = gate + cnd * 9216;
        const int row0 = u.pm * 256 + wr * 64 + fr, col0 = u.pn * 256 + wc * 32 + 4 * fq;
#pragma unroll
        for (int bj = 0; bj < 2; ++bj)
#pragma unroll
            for (int n = 0; n < 2; ++n) {
                const int col = col0 + bj * 128 + n * 16;
                const f32x4 gv = *(const f32x4*)(gp + col) * gs;
#pragma unroll
                for (int ai = 0; ai < 2; ++ai)
#pragma unroll
                    for (int m = 0; m < 4; ++m) { float* p = X + (size_t)(row0 + ai * 128 + m * 16) * 1024 + col; f32x4 x = *(const f32x4*)p; x += gv * acc[ai][bj][m][n]; *(f32x4*)p = x; }
            }
    }
};
struct EpiF32 {
    static constexpr bool PERM = false, AFTER_DRAIN = false;
    float* C; int ldc;
    __device__ __forceinline__ void operator()(const f32x4 (&acc)[2][2][4][2], const Unit& u, int wr, int wc, int fr, int fq) const {
        const int row0 = u.pm * 256 + wr * 64 + fr, col0 = u.pn * 256 + wc * 32 + 4 * fq;
#pragma unroll
        for (int ai = 0; ai < 2; ++ai)
#pragma unroll
            for (int m = 0; m < 4; ++m) { float* rp = C + (size_t)(row0 + ai * 128 + m * 16) * ldc + col0;
#pragma unroll
                for (int bj = 0; bj < 2; ++bj)
#pragma unroll
                    for (int n = 0; n < 2; ++n) *(f32x4*)(rp + bj * 128 + n * 16) = acc[ai][bj][m][n]; }
    }
};
struct EpiGLU {
    static constexpr bool PERM = true, AFTER_DRAIN = false;
    const float* Z; const float* bias; bf16_t* O;
    __device__ __forceinline__ void operator()(const f32x4 (&acc)[2][2][4][2], const Unit& u, int wr, int wc, int fr, int fq) const {
        const int row0 = u.pm * 256 + wr * 64 + fr, col0 = u.pn * 256 + wc * 32 + 8 * fq;
#pragma unroll
        for (int bj = 0; bj < 2; ++bj) {
            const int col = col0 + bj * 128;
            const f32x4 b0 = *(const f32x4*)(bias + col), b1 = *(const f32x4*)(bias + col + 4);
#pragma unroll
            for (int ai = 0; ai < 2; ++ai)
#pragma unroll
                for (int m = 0; m < 4; ++m) {
                    const int row = row0 + ai * 128 + m * 16;
                    const f32x4 z0 = *(const f32x4*)(Z + (size_t)row * 512 + col), z1 = *(const f32x4*)(Z + (size_t)row * 512 + col + 4);
                    f32x4 v0, v1;
#pragma unroll
                    for (int j = 0; j < 4; ++j) { v0[j] = z0[j] * sigmoidf_(acc[ai][bj][m][0][j] + b0[j]); v1[j] = z1[j] * sigmoidf_(acc[ai][bj][m][1][j] + b1[j]); }
                    *(u32x4*)(O + (size_t)row * 1024 + col) = pack8(v0, v1);
                }
        }
    }
};
struct EpiConvIn {
    static constexpr bool PERM = true, AFTER_DRAIN = false;
    bf16_t* ZC; bf16_t* GB;
    __device__ __forceinline__ void operator()(const f32x4 (&acc)[2][2][4][2], const Unit& u, int wr, int wc, int fr, int fq) const {
        const int row0 = u.pm * 256 + wr * 64 + fr;
        if (u.pn < 8) {
            const int col0 = u.pn * 128 + wc * 32 + 8 * fq;
#pragma unroll
            for (int ai = 0; ai < 2; ++ai)
#pragma unroll
                for (int m = 0; m < 4; ++m)
                    *(u32x4*)(ZC + (size_t)(row0 + ai * 128 + m * 16) * 1024 + col0) = pack8(acc[ai][0][m][0] * acc[ai][1][m][0], acc[ai][0][m][1] * acc[ai][1][m][1]);
        } else {
            const int col0 = (u.pn - 8) * 256 + wc * 32 + 8 * fq;
#pragma unroll
            for (int ai = 0; ai < 2; ++ai)
#pragma unroll
                for (int m = 0; m < 4; ++m)
#pragma unroll
                    for (int bj = 0; bj < 2; ++bj)
                        *(u32x4*)(GB + (size_t)(row0 + ai * 128 + m * 16) * 1024 + col0 + bj * 128) = pack8(acc[ai][bj][m][0], acc[ai][bj][m][1]);
        }
    }
};

__device__ __forceinline__ void transpose_item(const float* W, int K, int N, bf16_t* WT, int drow0, LAS float* scr, int kb, int n0, int lane) {
    const int k0 = 64 * kb;
#pragma unroll 8
    for (int i = 0; i < 32; ++i) { const int kk = 2 * i + (lane >> 5); scr[kk * 33 + (lane & 31)] = W[(size_t)(k0 + kk) * N + n0 + (lane & 31)]; }
    LDS_WAIT();
    const int c = lane & 7;
#pragma unroll
    for (int j = 0; j < 4; ++j) { const int n = (lane >> 3) + 8 * j; const LAS float* s = scr + (8 * c) * 33 + n;
        u32x4 o; o.x = cvt_pk_bf16(s[0 * 33], s[1 * 33]); o.y = cvt_pk_bf16(s[2 * 33], s[3 * 33]); o.z = cvt_pk_bf16(s[4 * 33], s[5 * 33]); o.w = cvt_pk_bf16(s[6 * 33], s[7 * 33]);
        *(u32x4*)(WT + (size_t)(drow0 + n) * K + k0 + 8 * c) = o; }
    LDS_WAIT();
}
__device__ __forceinline__ int gu_row(int n0, int up) { return 256 * (n0 >> 7) + (n0 & 127) + (up ? 128 : 0); }

__device__ __forceinline__ void phase0(LAS unsigned char* lds, const float* const* in, unsigned char* ws, int tid, int wave, int lane) {
    const int G = gridDim.x;
    LAS float* SIL = (LAS float*)(lds + 69632);
    LAS float* PART = (LAS float*)(lds + 81920);
    for (int i = tid; i < 3072; i += 512) { const int c = i >> 10, k = i & 1023; const float v = (c == 0) ? in[7][k] : in[6][(c - 1) * 1024 + k]; SIL[i] = v * sigmoidf_(v); }
    __syncthreads();
    float* mods = (float*)(ws + WS_MODS);
    for (int item = blockIdx.x; item < 288; item += G) {
        const int l = item / 144, j0 = (item % 144) * 64;
        const float* W = in[8] + (size_t)l * 1024 * 9216 + j0 + lane;
        float a0 = 0.f, a1 = 0.f, a2 = 0.f;
#pragma unroll 16
        for (int kk = 0; kk < 128; ++kk) { const int k = wave * 128 + kk; const float w = W[(size_t)k * 9216]; a0 = fmaf(SIL[k], w, a0); a1 = fmaf(SIL[1024 + k], w, a1); a2 = fmaf(SIL[2048 + k], w, a2); }
        PART[(wave * 3 + 0) * 64 + lane] = a0; PART[(wave * 3 + 1) * 64 + lane] = a1; PART[(wave * 3 + 2) * 64 + lane] = a2;
        __syncthreads();
        if (tid < 192) { const int c = tid >> 6, ln = tid & 63; float s = in[9][l * 9216 + j0 + ln];
#pragma unroll
            for (int w = 0; w < 8; ++w) s += PART[(w * 3 + c) * 64 + ln];
            mods[(size_t)(l * 3 + c) * 9216 + j0 + ln] = s; }
        __syncthreads();
    }
    LAS float* scr = (LAS float*)(lds + wave * 8448);
    const int gw = blockIdx.x * 8 + wave, NGW = G * 8;
    bf16_t* Wgu = (bf16_t*)(ws + WS_WGU); bf16_t* Wd = (bf16_t*)(ws + WS_WD);
    for (int it = gw; it < 20448; it += NGW) {
        int r = it;
        if (r < 16896) {
            const int lf = r / 4224, rr = r % 4224, which = rr / 1408, q = rr % 1408;
            if (which < 2) { const int kb = q / 88, n0 = 32 * (q % 88); transpose_item((which ? in[12] : in[11]) + (size_t)lf * 1024 * 2816, 1024, 2816, Wgu + (size_t)lf * WGU_EL, gu_row(n0, which), scr, kb, n0, lane); }
            else { const int kb = q / 32, n0 = 32 * (q % 32); transpose_item(in[13] + (size_t)lf * 2816 * 1024, 2816, 1024, Wd + (size_t)lf * WD_EL, n0, scr, kb, n0, lane); }
            continue;
        }
        r -= 16896;
        if (r < 592) { transpose_item(in[14], 1024, 1184, (bf16_t*)(ws + WS_WIN), 32 * (r % 37), scr, r / 37, 32 * (r % 37), lane); continue; } r -= 592;
        if (r < 144) { transpose_item(in[17], 384, 768, (bf16_t*)(ws + WS_WUQ), 32 * (r % 24), scr, r / 24, 32 * (r % 24), lane); continue; } r -= 144;
        if (r < 128) { transpose_item(in[18], 256, 1024, (bf16_t*)(ws + WS_WUKV), 32 * (r % 32), scr, r / 32, 32 * (r % 32), lane); continue; } r -= 128;
        if (r < 128) { transpose_item(in[29], 512, 512, (bf16_t*)(ws + WS_WGLU), 32 * (r % 16), scr, r / 16, 32 * (r % 16), lane); continue; } r -= 128;
        if (r < 512) { transpose_item(in[31], 1024, 1024, (bf16_t*)(ws + WS_WOUT), 32 * (r % 32), scr, r / 32, 32 * (r % 32), lane); continue; } r -= 512;
        if (r < 1536) { const int n0 = 32 * (r % 96); const int drow = n0 < 1024 ? 2048 + n0 : (n0 < 2048 ? gu_row(n0 - 1024, 0) : gu_row(n0 - 2048, 1));
            transpose_item(in[32], 1024, 3072, (bf16_t*)(ws + WS_WCIN), drow, scr, r / 96, n0, lane); continue; } r -= 1536;
        transpose_item(in[34], 1024, 1024, (bf16_t*)(ws + WS_WCOUT), 32 * (r % 32), scr, r / 32, 32 * (r % 32), lane);
    }
    { u32x4* zp = (u32x4*)((bf16_t*)(ws + WS_WIN) + (size_t)1184 * 1024); const u32x4 z = {0u, 0u, 0u, 0u};
      for (int i = blockIdx.x * 512 + tid; i < 12288; i += G * 512) zp[i] = z; }
}

__device__ __forceinline__ void normmod_phase(const float* src0, const float* src1, float* xcopy, bf16_t* H, const float* g, const float* mods_l, int si, int wave, int lane) {
    const int gw = blockIdx.x * 8 + wave, NGW = gridDim.x * 8;
    for (int row = gw; row < NTOK; row += NGW) {
        const float* xr = (row < NPR) ? src0 + (size_t)row * 1024 : src1 + (size_t)(row - NPR) * 1024;
        const float* sh = mods_l + cond_of_row(row) * 9216 + (3 * si) * 1024; const float* sc = sh + 1024;
        f32x4 v[4]; float ss = 0.f;
#pragma unroll
        for (int j = 0; j < 4; ++j) { v[j] = *(const f32x4*)(xr + 4 * lane + 256 * j); ss += (v[j][0] * v[j][0] + v[j][1] * v[j][1]) + (v[j][2] * v[j][2] + v[j][3] * v[j][3]); }
        const float rstd = rsqrtf(wave_sum(ss) * (1.0f / 1024.0f) + 1e-6f);
#pragma unroll
        for (int j = 0; j < 4; ++j) {
            const int c = 4 * lane + 256 * j;
            if (xcopy) *(f32x4*)(xcopy + (size_t)row * 1024 + c) = v[j];
            const f32x4 gg = *(const f32x4*)(g + c), s1 = *(const f32x4*)(sc + c), s0 = *(const f32x4*)(sh + c);
            const f32x4 o = v[j] * rstd * gg * (s1 + 1.0f) + s0;
            u32x2 w; w.x = cvt_pk_bf16(o[0], o[1]); w.y = cvt_pk_bf16(o[2], o[3]);
            *(u32x2*)(H + (size_t)row * 1024 + c) = w;
        }
    }
}

__device__ __forceinline__ int kv_row_of_tok(int r) { return r < NPR ? r : NPR + ((r - NPR) >> 11) * 2560 + 512 + ((r - NPR) & 2047); }

__device__ __forceinline__ void post1_rows(const float* const* in, const float* proj, bf16_t* cqn, bf16_t* ckvn, float* kr32, float* out, int wave, int lane) {
    const int gw = blockIdx.x * 8 + wave, NGW = gridDim.x * 8;
    const float* gq = in[15]; const float* gkv = in[16];
    for (int r = gw; r < NTOK + 1024; r += NGW) {
        if (r < NTOK) {
            const float* pr = proj + (size_t)r * 1280;
            float cq[6]; float ss = 0.f;
#pragma unroll
            for (int j = 0; j < 6; ++j) { cq[j] = pr[lane + 64 * j]; ss += cq[j] * cq[j]; }
            const float rq = rsqrtf(wave_sum(ss) * (1.0f / 384.0f) + 1e-6f);
#pragma unroll
            for (int j = 0; j < 6; ++j) { const float o = cq[j] * rq * gq[lane + 64 * j]; cqn[(size_t)r * 384 + lane + 64 * j] = (bf16_t)(cvt_pk_bf16(o, 0.f) & 0xffffu); }
            const f32x4 kv = *(const f32x4*)(pr + 384 + 4 * lane);
            const float rk = rsqrtf(wave_sum((kv[0] * kv[0] + kv[1] * kv[1]) + (kv[2] * kv[2] + kv[3] * kv[3])) * (1.0f / 256.0f) + 1e-6f);
            const f32x4 o = kv * rk * *(const f32x4*)(gkv + 4 * lane);
            const int kvr = kv_row_of_tok(r);
            u32x2 w; w.x = cvt_pk_bf16(o[0], o[1]); w.y = cvt_pk_bf16(o[2], o[3]);
            *(u32x2*)(ckvn + (size_t)kvr * 256 + 4 * lane) = w;
            if (r < NPR) *(f32x4*)(out + OUT_CKV + (size_t)r * 256 + 4 * lane) = o;
            if (lane < 32) { const float kr = pr[640 + lane]; kr32[(size_t)kvr * 32 + lane] = kr; if (r < NPR) out[OUT_KR + (size_t)r * 32 + lane] = kr; }
        } else {
            const int i = r - NTOK, b = i >> 9, j = i & 511, kvr = NPR + b * 2560 + j;
            const f32x4 o = *(const f32x4*)(in[2] + (size_t)i * 256 + 4 * lane);
            u32x2 w; w.x = cvt_pk_bf16(o[0], o[1]); w.y = cvt_pk_bf16(o[2], o[3]);
            *(u32x2*)(ckvn + (size_t)kvr * 256 + 4 * lane) = w;
            if (lane < 32) kr32[(size_t)kvr * 32 + lane] = in[3][(size_t)i * 32 + lane];
        }
    }
}

__device__ __forceinline__ void s5_setup(const float* const* in, int dir, int g, int lane, LAS bf16_t* scrB, float& ar, float& ai, bf16x8 (&BmA)[8], bf16x8 (&CmA)[4]) {
    const int idx = dir * 32 + g, p = lane;
    const float dt = expf(in[23][idx]);
    const float lr = fminf(in[21][idx * 64 + p], -1e-4f), li = in[22][idx * 64 + p];
    const float mag = expf(lr * dt); float sn, cs; sincos_acc(li * dt, sn, cs);
    ar = mag * cs; ai = mag * sn;
    const float den = lr * lr + li * li, nr = ar - 1.0f, ni = ai;
    const float core = (nr * lr + ni * li) / den, coim = (ni * lr - nr * li) / den;
    const float* bre = in[24] + (size_t)(idx * 64 + p) * 16; const float* bim = in[25] + (size_t)(idx * 64 + p) * 16;
#pragma unroll
    for (int h = 0; h < 2; ++h) {
        const f32x4 r0 = *(const f32x4*)(bre + 8 * h), r1 = *(const f32x4*)(bre + 8 * h + 4), i0 = *(const f32x4*)(bim + 8 * h), i1 = *(const f32x4*)(bim + 8 * h + 4);
        *(LAS u32x4*)(scrB + p * 16 + 8 * h) = pack8(r0 * core - i0 * coim, r1 * core - i1 * coim);
        *(LAS u32x4*)(scrB + (64 + p) * 16 + 8 * h) = pack8(i0 * core + r0 * coim, i1 * core + r1 * coim);
    }
    LDS_WAIT();
    const int rw = lane & 15, kq = lane >> 4;
    const bf16x8 zero8 = {0, 0, 0, 0, 0, 0, 0, 0};
#pragma unroll
    for (int blk = 0; blk < 8; ++blk) BmA[blk] = (kq < 2) ? *(const LAS bf16x8*)(scrB + (16 * blk + rw) * 16 + 8 * kq) : zero8;
    LDS_WAIT();
    const float* cre = in[26] + (size_t)(idx * 16 + rw) * 64 + 8 * kq; const float* cim = in[27] + (size_t)(idx * 16 + rw) * 64 + 8 * kq;
#pragma unroll
    for (int kk = 0; kk < 2; ++kk) {
        CmA[kk] = pack8v(*(const f32x4*)(cre + 32 * kk), *(const f32x4*)(cre + 32 * kk + 4));
        CmA[2 + kk] = pack8v(-*(const f32x4*)(cim + 32 * kk), -*(const f32x4*)(cim + 32 * kk + 4));
    }
}

template <bool WANT_Y>
__device__ __forceinline__ void s5_pass(int dir, int g, int tok0, float& sr, float& si, float ar, float ai, const bf16x8 (&BmA)[8], const bf16x8 (&CmA)[4],
                                        const float* proj, float* ybuf, bf16_t* zb, const float* s5d, LAS float* BUs, LAS bf16_t* Sm, int lane) {
    const int tl = lane & 15, kq = lane >> 4;
    const bf16x8 zero8 = {0, 0, 0, 0, 0, 0, 0, 0};
    for (int sc = 0; sc < 16; ++sc) {
        const int sub = dir ? 15 - sc : sc, t0 = tok0 + 16 * sub;
        bf16x8 ub = zero8;
        if (kq < 2) { const float* up = proj + (size_t)(t0 + tl) * 1280 + 672 + 16 * g + 8 * kq; ub = pack8v(*(const f32x4*)up, *(const f32x4*)(up + 4)); }
#pragma unroll
        for (int blk = 0; blk < 8; ++blk) {
            const f32x4 acc = __builtin_amdgcn_mfma_f32_16x16x32_bf16(BmA[blk], ub, (f32x4){0.f, 0.f, 0.f, 0.f}, 0, 0, 0);
            *(LAS f32x4*)(BUs + tl * 132 + 16 * blk + 4 * kq) = acc;
        }
        LDS_WAIT();
#pragma unroll
        for (int tt = 0; tt < 16; ++tt) {
            const int t = dir ? 15 - tt : tt;
            const float br = BUs[t * 132 + lane], bi = BUs[t * 132 + 64 + lane];
            const float nsr = fmaf(ar, sr, fmaf(-ai, si, br)), nsi = fmaf(ar, si, fmaf(ai, sr, bi));
            sr = nsr; si = nsi;
            if (WANT_Y) { const unsigned pk = cvt_pk_bf16(sr, si); Sm[t * 136 + lane] = (bf16_t)(pk & 0xffffu); Sm[t * 136 + 64 + lane] = (bf16_t)(pk >> 16); }
        }
        if (WANT_Y) {
            LDS_WAIT();
            f32x4 y = {0.f, 0.f, 0.f, 0.f};
#pragma unroll
            for (int kk = 0; kk < 4; ++kk) { const bf16x8 sb = *(const LAS bf16x8*)(Sm + tl * 136 + 32 * kk + 8 * kq); y = __builtin_amdgcn_mfma_f32_16x16x32_bf16(CmA[kk], sb, y, 0, 0, 0); }
            const size_t off = (size_t)(t0 + tl) * 512 + 16 * g + 4 * kq;
            if (dir == 0) { *(f32x4*)(ybuf + off) = y; }
            else {
                const f32x4 prev = *(const f32x4*)(ybuf + off), uu = *(const f32x4*)(proj + (size_t)(t0 + tl) * 1280 + 672 + 16 * g + 4 * kq), dd = *(const f32x4*)(s5d + 16 * g + 4 * kq);
                f32x4 v = dd * uu + prev + y;
#pragma unroll
                for (int j = 0; j < 4; ++j) v[j] = gelu_tanh(v[j]);
                *(f32x4*)(ybuf + off) = v;
                u32x2 w; w.x = cvt_pk_bf16(v[0], v[1]); w.y = cvt_pk_bf16(v[2], v[3]);
                *(u32x2*)(zb + off) = w;
            }
            LDS_WAIT();
        }
    }
}

__device__ __forceinline__ void s5_phase(LAS unsigned char* lds, const float* const* in, const float* proj, float* ybuf, bf16_t* zb, float* out, int wave, int lane) {
    LAS float* BUs = (LAS float*)(lds + wave * 12800);
    LAS bf16_t* Sm = (LAS bf16_t*)(lds + wave * 12800 + 8448);
    LAS float* CA = (LAS float*)(lds + 102400);
    const float* s5d = in[28];
    bf16x8 BmA[8], CmA[4]; float ar, ai;
    for (int u = blockIdx.x; u < 192; u += gridDim.x) {
        if (u < 64) {
            const int b = u >> 5, g = u & 31, tok0 = NPR + b * 2048 + 256 * wave;
            for (int dir = 0; dir < 2; ++dir) {
                s5_setup(in, dir, g, lane, (LAS bf16_t*)BUs, ar, ai, BmA, CmA);
                float xr = ar, xi = ai;
#pragma unroll
                for (int q = 0; q < 8; ++q) { const float nr = xr * xr - xi * xi, ni = 2.0f * xr * xi; xr = nr; xi = ni; }
                float sr = 0.f, si = 0.f;
                s5_pass<false>(dir, g, tok0, sr, si, ar, ai, BmA, CmA, proj, ybuf, zb, s5d, BUs, Sm, lane);
                CA[wave * 128 + lane] = sr; CA[wave * 128 + 64 + lane] = si;
                __syncthreads();
                float ir = in[4][(size_t)((b * 2 + dir) * 32 + g) * 64 + lane], ii = in[5][(size_t)((b * 2 + dir) * 32 + g) * 64 + lane];
                if (dir == 0) { for (int c = 0; c < wave; ++c) { const float nr = xr * ir - xi * ii + CA[c * 128 + lane], ni = xr * ii + xi * ir + CA[c * 128 + 64 + lane]; ir = nr; ii = ni; } }
                else { for (int c = 7; c > wave; --c) { const float nr = xr * ir - xi * ii + CA[c * 128 + lane], ni = xr * ii + xi * ir + CA[c * 128 + 64 + lane]; ir = nr; ii = ni; } }
                __syncthreads();
                sr = ir; si = ii;
                s5_pass<true>(dir, g, tok0, sr, si, ar, ai, BmA, CmA, proj, ybuf, zb, s5d, BUs, Sm, lane);
            }
        } else {
            const int id = (u - 64) * 8 + wave, b = id >> 5, g = id & 31, tok0 = b * 256;
            for (int dir = 0; dir < 2; ++dir) {
                s5_setup(in, dir, g, lane, (LAS bf16_t*)BUs, ar, ai, BmA, CmA);
                float sr = 0.f, si = 0.f;
                s5_pass<true>(dir, g, tok0, sr, si, ar, ai, BmA, CmA, proj, ybuf, zb, s5d, BUs, Sm, lane);
                out[OUT_SRE + (size_t)((b * 2 + dir) * 32 + g) * 64 + lane] = sr;
                out[OUT_SIM + (size_t)((b * 2 + dir) * 32 + g) * 64 + lane] = si;
            }
        }
    }
}

constexpr float QSCALE = 0.14724350f;
__device__ __forceinline__ void post2_phase(LAS unsigned char* lds, const float* kvraw, const float* kr32, const float* qraw, const float* gkn, const float* gqn,
                                            bf16_t* Kb, bf16_t* Vt, bf16_t* Qb, int tid, int wave, int lane) {
    LAS bf16_t* Vsm = (LAS bf16_t*)lds;
    LAS float* RC = (LAS float*)(lds + 73728);
    { const int pos = tid >> 3, i = tid & 7; const float invf = fexp2(-(float)i * (13.287712379549449f / 8.0f)); float sn, cs; sincos_acc((float)pos * invf, sn, cs); RC[tid] = cs; RC[512 + tid] = sn; }
    __syncthreads();
    const int h = lane >> 3, j = lane & 7;
    f32x4 gk[4], gq[4];
#pragma unroll
    for (int i = 0; i < 4; ++i) { gk[i] = (j < 6) ? *(const f32x4*)(gkn + 16 * j + 4 * i) : (f32x4){0.f, 0.f, 0.f, 0.f}; gq[i] = (j < 6) ? *(const f32x4*)(gqn + 16 * j + 4 * i) : (f32x4){0.f, 0.f, 0.f, 0.f}; }
    for (int ku = blockIdx.x; ku < 208; ku += gridDim.x) {
        const int row0 = 64 * ku; const bool samp = row0 >= NPR;
        int key0, Lk; size_t vt0;
        if (!samp) { const int e = row0 >> 8; key0 = row0 & 255; Lk = 256; vt0 = (size_t)e * 8 * 64 * 256; }
        else { const int rr = row0 - NPR, e = rr / 2560; key0 = rr % 2560; Lk = 2560; vt0 = VT_S + (size_t)e * 8 * 64 * 2560; }
        const bool rope = samp && key0 >= 512;
        for (int i = 0; i < 8; ++i) {
            const int kl = 8 * wave + i, row = row0 + kl;
            f32x4 v[4]; float ss = 0.f;
            const float* src = (j < 4) ? kvraw + (size_t)row * 1024 + 128 * h + 16 * j : kr32 + (size_t)row * 32 + 16 * (j & 1);
#pragma unroll
            for (int q = 0; q < 4; ++q) { v[q] = (j < 6) ? *(const f32x4*)(src + 4 * q) : (f32x4){0.f, 0.f, 0.f, 0.f}; ss += (v[q][0] * v[q][0] + v[q][1] * v[q][1]) + (v[q][2] * v[q][2] + v[q][3] * v[q][3]); }
            ss += __shfl_xor(ss, 1); ss += __shfl_xor(ss, 2); ss += __shfl_xor(ss, 4);
            const float rstd = rsqrtf(ss * (1.0f / 96.0f) + 1e-6f);
#pragma unroll
            for (int q = 0; q < 4; ++q) v[q] = v[q] * rstd * gk[q];
            if (rope && j >= 4 && j < 6) {
                const int t = key0 - 512 + kl, pos = (j == 4) ? (t >> 6) : (t & 63);
#pragma unroll
                for (int q = 0; q < 2; ++q)
#pragma unroll
                    for (int e2 = 0; e2 < 4; ++e2) { const float cs = RC[pos * 8 + 4 * q + e2], sn = RC[512 + pos * 8 + 4 * q + e2]; const float x1 = v[q][e2], x2 = v[2 + q][e2]; v[q][e2] = x1 * cs - x2 * sn; v[2 + q][e2] = x1 * sn + x2 * cs; }
            }
            if (j < 6) { bf16_t* kp = Kb + (size_t)row * 768 + 96 * h + 16 * j; *(u32x4*)kp = pack8(v[0], v[1]); *(u32x4*)(kp + 8) = pack8(v[2], v[3]); }
            const float* vs = kvraw + (size_t)row * 1024 + 128 * h + 64 + 8 * j;
            const f32x4 a = *(const f32x4*)vs, b = *(const f32x4*)(vs + 4);
            const u32x4 pk = pack8(a, b);
            LAS bf16_t* vd = Vsm + (64 * h + 8 * j) * 72 + kl;
            vd[0 * 72] = (bf16_t)(pk.x & 0xffffu); vd[1 * 72] = (bf16_t)(pk.x >> 16); vd[2 * 72] = (bf16_t)(pk.y & 0xffffu); vd[3 * 72] = (bf16_t)(pk.y >> 16);
            vd[4 * 72] = (bf16_t)(pk.z & 0xffffu); vd[5 * 72] = (bf16_t)(pk.z >> 16); vd[6 * 72] = (bf16_t)(pk.w & 0xffffu); vd[7 * 72] = (bf16_t)(pk.w >> 16);
        }
        __syncthreads();
#pragma unroll
        for (int it = 0; it < 8; ++it) { const int col = 64 * wave + 8 * it + (lane >> 3), ch = lane & 7;
            const u32x4 d = *(const LAS u32x4*)(Vsm + col * 72 + 8 * ch);
            *(u32x4*)(Vt + vt0 + (size_t)col * Lk + key0 + 8 * ch) = d; }
        __syncthreads();
    }
    const int gw = blockIdx.x * 8 + wave, NGW = gridDim.x * 8;
    for (int r = gw; r < NTOK; r += NGW) {
        f32x4 v[4]; float ss = 0.f;
        const float* src = qraw + (size_t)r * 768 + 96 * h + 16 * (j < 6 ? j : 0);
#pragma unroll
        for (int q = 0; q < 4; ++q) { v[q] = (j < 6) ? *(const f32x4*)(src + 4 * q) : (f32x4){0.f, 0.f, 0.f, 0.f}; ss += (v[q][0] * v[q][0] + v[q][1] * v[q][1]) + (v[q][2] * v[q][2] + v[q][3] * v[q][3]); }
        ss += __shfl_xor(ss, 1); ss += __shfl_xor(ss, 2); ss += __shfl_xor(ss, 4);
        const float rstd = rsqrtf(ss * (1.0f / 96.0f) + 1e-6f) * QSCALE;
#pragma unroll
        for (int q = 0; q < 4; ++q) v[q] = v[q] * rstd * gq[q];
        if (r >= NPR && j >= 4 && j < 6) {
            const int t = (r - NPR) & 2047, pos = (j == 4) ? (t >> 6) : (t & 63);
#pragma unroll
            for (int q = 0; q < 2; ++q)
#pragma unroll
                for (int e2 = 0; e2 < 4; ++e2) { const float cs = RC[pos * 8 + 4 * q + e2], sn = RC[512 + pos * 8 + 4 * q + e2]; const float x1 = v[q][e2], x2 = v[2 + q][e2]; v[q][e2] = x1 * cs - x2 * sn; v[2 + q][e2] = x1 * sn + x2 * cs; }
        }
        if (j < 6) { bf16_t* qp = Qb + (size_t)r * 768 + 96 * h + 16 * j; *(u32x4*)qp = pack8(v[0], v[1]); *(u32x4*)(qp + 8) = pack8(v[2], v[3]); }
    }
}

__device__ __forceinline__ void attn_phase(LAS unsigned char* lds, const bf16_t* Qb, const bf16_t* Kb, const bf16_t* Vt, bf16_t* CAT, int tid, int wave, int lane, int u_lo, int u_hi) {
    const int rg = wave & 3, kp = wave >> 2, l31 = lane & 31, hh = lane >> 5;
    const int pi = 16 * (l31 >> 4) + 8 * ((l31 >> 2) & 1) + 4 * ((l31 >> 3) & 1) + (l31 & 3);
    LAS unsigned char* Ks = lds; LAS unsigned char* Vs = lds + 26624; LAS float* CB = (LAS float*)(lds + 45056);
    int krow[3], kc[3], vrow[2], vc[2];
#pragma unroll
    for (int i = 0; i < 3; ++i) { const int idx = tid + 512 * i; krow[i] = idx / 12; kc[i] = idx % 12; }
#pragma unroll
    for (int i = 0; i < 2; ++i) { const int idx = tid + 512 * i; vrow[i] = idx >> 4; vc[i] = idx & 15; }
    for (int u = u_lo + blockIdx.x; u < u_hi; u += gridDim.x) {
        int h, q0, kvrow0, Lk; size_t vt0;
        if (u < 256) { const int e = u >> 7, qb = u & 15; h = (u >> 4) & 7; q0 = NPR + e * 2048 + qb * 128; kvrow0 = NPR + e * 2560; Lk = 2560; vt0 = VT_S + (size_t)((e * 8 + h) * 64) * 2560; }
        else { const int uu = u - 256, e = uu >> 4, qb = uu & 1; h = (uu >> 1) & 7; q0 = e * 256 + qb * 128; kvrow0 = e * 256; Lk = 256; vt0 = (size_t)((e * 8 + h) * 64) * 256; }
        bf16x8 qreg[6];
        { const bf16_t* qp = Qb + (size_t)(q0 + 32 * rg + l31) * 768 + 96 * h + 8 * hh;
#pragma unroll
          for (int kk = 0; kk < 6; ++kk) qreg[kk] = *(const bf16x8*)(qp + 16 * kk); }
        f32x16 o0, o1;
#pragma unroll
        for (int jj = 0; jj < 16; ++jj) { o0[jj] = 0.f; o1[jj] = 0.f; }
        float m = -1e30f, lsum = 0.f;
        const int nit = Lk >> 7;
        u32x4 kst[3], vst[2];
        const bf16_t* kbase_g = Kb + (size_t)kvrow0 * 768 + 96 * h; const bf16_t* vbase_g = Vt + vt0;
#define ATT_PREFETCH(it) do { _Pragma("unroll") for (int i = 0; i < 3; ++i) kst[i] = *(const u32x4*)(kbase_g + (size_t)(128 * (it) + krow[i]) * 768 + 8 * kc[i]); \
                              _Pragma("unroll") for (int i = 0; i < 2; ++i) vst[i] = *(const u32x4*)(vbase_g + (size_t)vrow[i] * Lk + 128 * (it) + 8 * vc[i]); } while (0)
        ATT_PREFETCH(0);
        for (int it = 0; it < nit; ++it) {
            __syncthreads();
#pragma unroll
            for (int i = 0; i < 3; ++i) *(LAS u32x4*)(Ks + krow[i] * 208 + kc[i] * 16) = kst[i];
#pragma unroll
            for (int i = 0; i < 2; ++i) *(LAS u32x4*)(Vs + vrow[i] * 272 + vc[i] * 16) = vst[i];
            __syncthreads();
            if (it + 1 < nit) ATT_PREFETCH(it + 1);
            for (int kpe = 0; kpe < 2; ++kpe) {
            f32x16 s0, s1;
#pragma unroll
            for (int jj = 0; jj < 16; ++jj) { s0[jj] = 0.f; s1[jj] = 0.f; }
            const LAS unsigned char* kb_l = Ks + (64 * kpe + pi) * 208 + 16 * hh;
#pragma unroll
            for (int kk = 0; kk < 6; ++kk) {
                const bf16x8 a0 = *(const LAS bf16x8*)(kb_l + 32 * kk), a1 = *(const LAS bf16x8*)(kb_l + 32 * 208 + 32 * kk);
                s0 = __builtin_amdgcn_mfma_f32_32x32x16_bf16(a0, qreg[kk], s0, 0, 0, 0);
                s1 = __builtin_amdgcn_mfma_f32_32x32x16_bf16(a1, qreg[kk], s1, 0, 0, 0);
            }
            float mx = fmaxf(s0[0], s1[0]);
#pragma unroll
            for (int jj = 1; jj < 16; ++jj) mx = fmaxf(mx, fmaxf(s0[jj], s1[jj]));
            mx = fmaxf(mx, __shfl_xor(mx, 32));
            const float mn = fmaxf(m, mx), alpha = fexp2(m - mn); m = mn;
            float rs = 0.f;
#pragma unroll
            for (int jj = 0; jj < 16; ++jj) { s0[jj] = fexp2(s0[jj] - mn); s1[jj] = fexp2(s1[jj] - mn); rs += s0[jj] + s1[jj]; }
            lsum = lsum * alpha + rs;
#pragma unroll
            for (int jj = 0; jj < 16; ++jj) { o0[jj] *= alpha; o1[jj] *= alpha; }
            const LAS unsigned char* vb_l = Vs + l31 * 272 + 128 * kpe + 16 * hh;
#pragma unroll
            for (int kb = 0; kb < 4; ++kb) {
                u32x4 pw;
                if (kb < 2) { pw.x = cvt_pk_bf16(s0[8 * kb + 0], s0[8 * kb + 1]); pw.y = cvt_pk_bf16(s0[8 * kb + 2], s0[8 * kb + 3]); pw.z = cvt_pk_bf16(s0[8 * kb + 4], s0[8 * kb + 5]); pw.w = cvt_pk_bf16(s0[8 * kb + 6], s0[8 * kb + 7]); }
                else { const int k2 = kb - 2; pw.x = cvt_pk_bf16(s1[8 * k2 + 0], s1[8 * k2 + 1]); pw.y = cvt_pk_bf16(s1[8 * k2 + 2], s1[8 * k2 + 3]); pw.z = cvt_pk_bf16(s1[8 * k2 + 4], s1[8 * k2 + 5]); pw.w = cvt_pk_bf16(s1[8 * k2 + 6], s1[8 * k2 + 7]); }
                const bf16x8 pb = __builtin_bit_cast(bf16x8, pw);
                const bf16x8 a0 = *(const LAS bf16x8*)(vb_l + 32 * kb), a1 = *(const LAS bf16x8*)(vb_l + 32 * 272 + 32 * kb);
                o0 = __builtin_amdgcn_mfma_f32_32x32x16_bf16(a0, pb, o0, 0, 0, 0);
                o1 = __builtin_amdgcn_mfma_f32_32x32x16_bf16(a1, pb, o1, 0, 0, 0);
            }
            }
        }
#undef ATT_PREFETCH
        if (kp == 0) {
#pragma unroll
            for (int jj = 0; jj < 16; ++jj) { CB[(rg * 34 + jj) * 64 + lane] = o0[jj]; CB[(rg * 34 + 16 + jj) * 64 + lane] = o1[jj]; }
            CB[(rg * 34 + 32) * 64 + lane] = m; CB[(rg * 34 + 33) * 64 + lane] = lsum;
        }
        __syncthreads();
        if (kp == 1) {
            const float m1 = CB[(rg * 34 + 32) * 64 + lane], l1 = CB[(rg * 34 + 33) * 64 + lane];
            const float mt = m, a0 = 1.0f, a1 = 0.0f * m1;
            float lt = lsum * a0 + 0.0f * l1; lt += __shfl_xor(lt, 32);
            const float inv = 1.0f / lt;
            bf16_t* op = CAT + (size_t)(q0 + 32 * rg + l31) * 1024 + 64 * h + 4 * hh;
#pragma unroll
            for (int g4 = 0; g4 < 4; ++g4) {
                u32x2 w0, w1; float t0[4], t1[4];
#pragma unroll
                for (int e2 = 0; e2 < 4; ++e2) { const int jj = 4 * g4 + e2; t0[e2] = (o0[jj] * a0 + CB[(rg * 34 + jj) * 64 + lane] * a1) * inv; t1[e2] = (o1[jj] * a0 + CB[(rg * 34 + 16 + jj) * 64 + lane] * a1) * inv; }
                w0.x = cvt_pk_bf16(t0[0], t0[1]); w0.y = cvt_pk_bf16(t0[2], t0[3]); w1.x = cvt_pk_bf16(t1[0], t1[1]); w1.y = cvt_pk_bf16(t1[2], t1[3]);
                *(u32x2*)(op + 8 * g4) = w0; *(u32x2*)(op + 32 + 8 * g4) = w1;
            }
        }
        __syncthreads();
    }
}


__device__ __forceinline__ void attn_simple(const bf16_t* Qb, const bf16_t* Kb, const bf16_t* Vt, bf16_t* CAT, int tid, int tok_lo, int tok_hi) {
    const int n = tok_hi * 8, stride = gridDim.x * 512;
    for (int idx = tok_lo * 8 + blockIdx.x * 512 + tid; idx < n; idx += stride) {
        const int tok = idx >> 3, h = idx & 7;
        int kvrow0, Lk; size_t vt0;
        if (tok < NPR) { const int e = tok >> 8; kvrow0 = e * 256; Lk = 256; vt0 = (size_t)((e * 8 + h) * 64) * 256; }
        else { const int e = (tok - NPR) >> 11; kvrow0 = NPR + e * 2560; Lk = 2560; vt0 = VT_S + (size_t)((e * 8 + h) * 64) * 2560; }
        unsigned q[48];
#pragma unroll
        for (int d = 0; d < 48; ++d) q[d] = *(const unsigned*)(Qb + (size_t)tok * 768 + 96 * h + 2 * d);
#pragma unroll 1
        for (int dc = 0; dc < 4; ++dc) {
        float o[16];
#pragma unroll
        for (int d = 0; d < 16; ++d) o[d] = 0.f;
        float m = -1e30f, l = 0.f;
        const bf16_t* vp = Vt + vt0 + (size_t)(16 * dc) * Lk;
#pragma unroll 1
        for (int key = 0; key < Lk; ++key) {
            const bf16_t* kp = Kb + (size_t)(kvrow0 + key) * 768 + 96 * h;
            float sdot = 0.f;
#pragma unroll
            for (int d = 0; d < 48; ++d) { const unsigned kw = *(const unsigned*)(kp + 2 * d); sdot = fmaf(__uint_as_float(q[d] << 16), __uint_as_float(kw << 16), sdot); sdot = fmaf(__uint_as_float(q[d] & 0xffff0000u), __uint_as_float(kw & 0xffff0000u), sdot); }
            const float mn = fmaxf(m, sdot), alpha = fexp2(m - mn), p = fexp2(sdot - mn); m = mn;
            l = l * alpha + p;
#pragma unroll
            for (int d = 0; d < 16; ++d) o[d] = o[d] * alpha + p * bf2f(vp[(size_t)d * Lk + key]);
        }
        const float inv = 1.0f / l;
#pragma unroll
        for (int d = 0; d < 16; d += 2) *(unsigned*)(CAT + (size_t)tok * 1024 + 64 * h + 16 * dc + d) = cvt_pk_bf16(o[d] * inv, o[d + 1] * inv);
        }
    }
}

__device__ __forceinline__ void conv_phase(const bf16_t* ZC, const bf16_t* GB, const float* cw, bf16_t* A, int tid) {
    const int n = NTOK * 128, stride = gridDim.x * 512;
    for (int idx = blockIdx.x * 512 + tid; idx < n; idx += stride) {
        const int tok = idx >> 7, c0 = (idx & 127) * 8;
        const int p = tok < NPR ? (tok & 255) : ((tok - NPR) & 2047), L = tok < NPR ? 256 : 2048;
        const u32x4 zero = {0u, 0u, 0u, 0u};
        const u32x4 zc = *(const u32x4*)(ZC + (size_t)tok * 1024 + c0);
        const u32x4 zp = (p > 0) ? *(const u32x4*)(ZC + (size_t)(tok - 1) * 1024 + c0) : zero;
        const u32x4 zn = (p < L - 1) ? *(const u32x4*)(ZC + (size_t)(tok + 1) * 1024 + c0) : zero;
        const u32x4 gb = *(const u32x4*)(GB + (size_t)tok * 1024 + c0);
        float w[24];
#pragma unroll
        for (int q = 0; q < 6; ++q) { const f32x4 t = *(const f32x4*)(cw + (size_t)c0 * 3 + 4 * q); w[4 * q] = t[0]; w[4 * q + 1] = t[1]; w[4 * q + 2] = t[2]; w[4 * q + 3] = t[3]; }
        float o[8];
#pragma unroll
        for (int e = 0; e < 8; ++e) {
            const unsigned wp = zp[e >> 1], wc_ = zc[e >> 1], wn = zn[e >> 1], wg = gb[e >> 1];
            const float fp = (e & 1) ? __uint_as_float(wp & 0xffff0000u) : __uint_as_float(wp << 16);
            const float fc = (e & 1) ? __uint_as_float(wc_ & 0xffff0000u) : __uint_as_float(wc_ << 16);
            const float fn = (e & 1) ? __uint_as_float(wn & 0xffff0000u) : __uint_as_float(wn << 16);
            const float fg = (e & 1) ? __uint_as_float(wg & 0xffff0000u) : __uint_as_float(wg << 16);
            o[e] = fg * (w[3 * e] * fp + w[3 * e + 1] * fc + w[3 * e + 2] * fn);
        }
        u32x4 r; r.x = cvt_pk_bf16(o[0], o[1]); r.y = cvt_pk_bf16(o[2], o[3]); r.z = cvt_pk_bf16(o[4], o[5]); r.w = cvt_pk_bf16(o[6], o[7]);
        *(u32x4*)(A + (size_t)tok * 1024 + c0) = r;
    }
}

#define XB_TMO      128
#define XB_XCNT(j)  (256  + 64 * (j))
#define XB_XSUB(j)  (1280 + 64 * (j))
#define XB_XGEN(j)  (2304 + 64 * (j))
#define XB_TOP      3328
#define XB_TOPGEN   3392
#define XCD_BAR_WORDS 3456
#define XB_SPIN_CAP (1u << 18)

__device__ __forceinline__ unsigned xb_ld(unsigned* p)              { return __hip_atomic_load(p, __ATOMIC_RELAXED, __HIP_MEMORY_SCOPE_AGENT); }
__device__ __forceinline__ unsigned xb_add(unsigned* p, unsigned v) { return __hip_atomic_fetch_add(p, v, __ATOMIC_RELAXED, __HIP_MEMORY_SCOPE_AGENT); }
__device__ __forceinline__ unsigned xb_xcc_id() { return (unsigned)__builtin_amdgcn_s_getreg((3 << 11) | 20) & 0xFu; }
#define XB_SPIN(cond, bar) do { unsigned _sp = 0; while (cond) { __builtin_amdgcn_s_sleep(1); \
    if ((++_sp & 255u) == 0u) { if (xb_ld(&(bar)[XB_TMO])) break; if (_sp > XB_SPIN_CAP) { atomicAdd(&(bar)[XB_TMO], 1u); break; } } } } while (0)

struct XcdBarrier {
    unsigned* bar; unsigned x;
    volatile LAS unsigned* st;
};

__device__ __forceinline__ XcdBarrier xcd_barrier_post(unsigned* bar, volatile LAS unsigned* st) {
    XcdBarrier b; b.bar = bar; b.x = xb_xcc_id(); b.st = st;
    if (threadIdx.x == 0) (void)xb_add(&bar[XB_XCNT(b.x)], 1u);
    return b;
}
__device__ __forceinline__ void xcd_barrier_complete(unsigned* bar, unsigned x, unsigned& nloc, unsigned& nx) {
    const unsigned G = gridDim.x * gridDim.y * gridDim.z;
    unsigned sum, cnt, mine, sp = 0u;
    for (;;) {
        sum = 0u; cnt = 0u; mine = 0u;
#pragma unroll
        for (unsigned j = 0; j < 16; ++j) { const unsigned c = xb_ld(&bar[XB_XCNT(j)]); sum += c; cnt += (c > 0u) ? 1u : 0u; mine = (j == x) ? c : mine; }
        if (sum == G) break;
        __builtin_amdgcn_s_sleep(1);
        if ((++sp & 255u) == 0u) { if (xb_ld(&bar[XB_TMO])) break; if (sp > XB_SPIN_CAP) { atomicAdd(&bar[XB_TMO], 1u); break; } }
    }
    nloc = mine > 0u ? mine : 1u; nx = cnt > 0u ? cnt : 1u;
}

__device__ __forceinline__ void xcd_barrier(const XcdBarrier& b) {
    asm volatile("s_waitcnt vmcnt(0)" ::: "memory");
    __syncthreads();
    if (threadIdx.x == 0) {
        unsigned* bar = b.bar;
        __builtin_amdgcn_s_waitcnt(0);
        unsigned nloc = b.st[0], nx = b.st[1];
        if (nloc == 0u) { xcd_barrier_complete(bar, b.x, nloc, nx); b.st[0] = nloc; b.st[1] = nx; }
        const unsigned old = xb_add(&bar[XB_XSUB(b.x)], 1u);
        const unsigned gen = old / nloc;
        if (old + 1u == (gen + 1u) * nloc) {
            __builtin_amdgcn_fence(__ATOMIC_RELEASE, "agent");
            asm volatile("s_waitcnt vmcnt(0)" ::: "memory");
            const unsigned og = xb_add(&bar[XB_TOP], 1u);
            const unsigned tg = og / nx;
            if (og + 1u == (tg + 1u) * nx) xb_add(&bar[XB_TOPGEN], 1u);
            else XB_SPIN(xb_ld(&bar[XB_TOPGEN]) == tg, bar);
            __builtin_amdgcn_fence(__ATOMIC_ACQUIRE, "agent");
            xb_add(&bar[XB_XGEN(b.x)], 1u);
            asm volatile("s_waitcnt vmcnt(0)" ::: "memory");
        } else {
            XB_SPIN(xb_ld(&bar[XB_XGEN(b.x)]) == gen, bar);
            __builtin_amdgcn_fence(__ATOMIC_ACQUIRE, "agent");
            asm volatile("s_waitcnt vmcnt(0)" ::: "memory");
        }
    }
    __syncthreads();
}

#ifndef MK_KINDS
#define MK_KINDS 0xFFFF
#endif
#define HAS(k) (((MK_KINDS) >> (k)) & 1)
#ifndef ABL_ULO
#define ABL_ULO 0
#define ABL_UHI 768
#define ABL_TLO 0
#define ABL_THI 0
#endif
struct Args { const float* in[35]; float* out; unsigned char* ws; int ph_lo, ph_hi; };

__global__ void __launch_bounds__(512, 2) mk_fwd(Args args) {
    extern __shared__ __attribute__((aligned(16))) unsigned char lds_raw[];
    LAS unsigned char* lds = (LAS unsigned char*)lds_raw;
    cg::grid_group grid = cg::this_grid();
    const int G = gridDim.x, bid = blockIdx.x;
    const float* const* in = args.in;
    unsigned char* ws = args.ws; float* out = args.out; float* X = out;
    float* mods = (float*)(ws + WS_MODS);
    bf16_t* H = (bf16_t*)(ws + WS_H); bf16_t* ACT = (bf16_t*)(ws + WS_ACT);
    float* PROJ = (float*)(ws + WS_PROJ); float* KVRAW = (float*)(ws + WS_KVRAW); float* QRAW = (float*)(ws + WS_QRAW);
    bf16_t* CQN = (bf16_t*)(ws + WS_CQN); bf16_t* CKVN = (bf16_t*)(ws + WS_CKVN); float* KR32 = (float*)(ws + WS_KR32);
    float* Z = (float*)(ws + WS_Z); bf16_t* ZB = (bf16_t*)(ws + WS_ZB);
    bf16_t* KB = (bf16_t*)(ws + WS_KB); bf16_t* VT = (bf16_t*)(ws + WS_VT); bf16_t* QB = (bf16_t*)(ws + WS_QB);
    bf16_t* ZC = (bf16_t*)(ws + WS_ZC); bf16_t* GBF = (bf16_t*)(ws + WS_GB);

    volatile LAS unsigned* bst = (volatile LAS unsigned*)(lds + 131072);
    if (threadIdx.x < 4) bst[threadIdx.x] = 0u;
    __syncthreads();
    XcdBarrier xbar = xcd_barrier_post((unsigned*)ws, bst);
    for (int ph = args.ph_lo; ph < args.ph_hi; ++ph) {
        int tid = threadIdx.x; asm volatile("" : "+v"(tid));
        const int lane = tid & 63, wave = __builtin_amdgcn_readfirstlane(tid >> 6);
        int kind, l = 0, sub = 0;
        if (ph == 0) kind = 0;
        else if (ph <= 13) { l = 0; const int q = ph - 1;
            kind = (q == 0 || q == 3 || q == 10) ? 1 : (q == 1 || q == 11) ? 2 : (q == 2 || q == 9 || q == 12) ? 3 : (q == 4) ? 4 : (q == 5) ? 5 : (q == 6) ? 6 : (q == 7) ? 7 : 8;
            sub = (q <= 2) ? 0 : (q <= 9) ? 1 : 2; }
        else { l = 1; const int q = ph - 14;
            kind = (q == 0 || q == 3 || q == 7) ? 1 : (q == 1 || q == 8) ? 2 : (q == 2 || q == 6 || q == 9) ? 3 : (q == 4) ? 9 : 10;
            sub = (q <= 2) ? 0 : (q <= 6) ? 1 : 2; }
        const float* mods_l = mods + (size_t)l * 3 * 9216;

        if (HAS(0) && kind == 0) phase0(lds, in, ws, tid, wave, lane);
        else if (HAS(1) && kind == 1) {
            const bool first = (ph == 1);
            normmod_phase(first ? in[0] : X, first ? in[1] : X + (size_t)NPR * 1024, first ? X : nullptr, H, in[10] + (size_t)(l * 3 + sub) * 1024, mods_l, sub, wave, lane);
        } else if (HAS(2) && kind == 2) {
            const int lf = l * 2 + (sub == 2 ? 1 : 0);
            pg8::Gemm g{H, (const bf16_t*)(ws + WS_WGU) + (size_t)lf * WGU_EL, NTOK, 5632, 1024}; pg8::StaticOrder S; S.init(NTOK, 5632, G, bid);
            EpiSwiGLU E{ACT};
            pg8::gemm_phase<EpiSwiGLU, pg8::StaticOrder, true, true>(lds, g, S, E, tid);
        } else if (HAS(3) && kind == 3) {
            pg8::Gemm g; float gs; int gi;
            if (sub == 1) { g = pg8::Gemm{H, (const bf16_t*)(ws + (l == 0 ? WS_WOUT : WS_WCOUT)), NTOK, 1024, 1024}; gs = 1.0f; gi = 5; }
            else { const int lf = l * 2 + (sub == 2 ? 1 : 0); g = pg8::Gemm{ACT, (const bf16_t*)(ws + WS_WD) + (size_t)lf * WD_EL, NTOK, 1024, 2816}; gs = 0.5f; gi = (sub == 0) ? 2 : 8; }
            pg8::StaticOrder S; S.init(NTOK, 1024, G, bid);
            EpiResid E{X, mods_l + gi * 1024, gs};
            pg8::gemm_phase<EpiResid, pg8::StaticOrder, true, true>(lds, g, S, E, tid);
        } else if (HAS(4) && (kind == 4 || kind == 6)) {
            const int ng = (kind == 4) ? 1 : 2;
            for (int gi = 0; gi < ng; ++gi) {
                pg8::Gemm g; EpiF32 E; int coff;
                if (kind == 4) { g = pg8::Gemm{H, (const bf16_t*)(ws + WS_WIN), NTOK, 1280, 1024}; E = EpiF32{PROJ, 1280}; coff = 0; }
                else if (gi == 0) { g = pg8::Gemm{CQN, (const bf16_t*)(ws + WS_WUQ), NTOK, 768, 384}; E = EpiF32{QRAW, 768}; coff = 0; }
                else { g = pg8::Gemm{CKVN, (const bf16_t*)(ws + WS_WUKV), NKV, 1024, 256}; E = EpiF32{KVRAW, 1024}; coff = 112; }
                pg8::StaticOrder S; S.init(g.M, g.N, G, (bid + coff) % G);
                pg8::gemm_phase<EpiF32, pg8::StaticOrder, true, true>(lds, g, S, E, tid);
            }
            if (HAS(6) && kind == 6) {
                pg8::Gemm g{ZB, (const bf16_t*)(ws + WS_WGLU), NTOK, 512, 512}; pg8::StaticOrder S; S.init(NTOK, 512, G, (bid + 160) % G);
                EpiGLU E{Z, in[30], H + 512};
                pg8::gemm_phase<EpiGLU, pg8::StaticOrder, true, true>(lds, g, S, E, tid);
            }
        } else if (HAS(5) && kind == 5) {
            post1_rows(in, PROJ, CQN, CKVN, KR32, out, wave, lane);
            s5_phase(lds, in, PROJ, Z, ZB, out, wave, lane);
        } else if (HAS(7) && kind == 7) {
            post2_phase(lds, KVRAW, KR32, QRAW, in[20], in[19], KB, VT, QB, tid, wave, lane);
        } else if (HAS(8) && kind == 8) {
            attn_phase(lds, QB, KB, VT, H, tid, wave, lane, ABL_ULO, ABL_UHI);
            attn_simple(QB, KB, VT, H, tid, ABL_TLO, ABL_THI);
        } else if (HAS(9) && kind == 9) {
            pg8::Gemm g{H, (const bf16_t*)(ws + WS_WCIN), NTOK, 3072, 1024}; pg8::StaticOrder S; S.init(NTOK, 3072, G, bid);
            EpiConvIn E{ZC, GBF};
            pg8::gemm_phase<EpiConvIn, pg8::StaticOrder, true, true>(lds, g, S, E, tid);
        } else if (HAS(10)) {
            conv_phase(ZC, GBF, in[33], H, tid);
        }
        if (ph + 1 < args.ph_hi) { if (ph == 0) grid.sync(); else xcd_barrier(xbar); }
    }
}

extern "C" void kernel_launch(void* const* d_in, const int* in_sizes, int n_in, void* d_out, int out_size, void* d_ws, size_t ws_size, hipStream_t stream) {
    static int grid = 0;
    if (grid == 0) {
        int dev = 0, cus = 0, per_cu = 0;
        if (n_in != 35 || ws_size < (size_t)280 * MiB) { fprintf(stderr, "kernel_launch: unexpected n_in %d / ws %zu\n", n_in, ws_size); grid = -1; return; }
        hipGetDevice(&dev); hipDeviceGetAttribute(&cus, hipDeviceAttributeMultiprocessorCount, dev);
        if (hipFuncSetAttribute((const void*)mk_fwd, hipFuncAttributeMaxDynamicSharedMemorySize, LDS_BYTES) != hipSuccess) { fprintf(stderr, "kernel_launch: hipFuncSetAttribute failed\n"); grid = -1; return; }
        if (hipOccupancyMaxActiveBlocksPerMultiprocessor(&per_cu, (const void*)mk_fwd, 512, LDS_BYTES) != hipSuccess || per_cu < 1) { fprintf(stderr, "kernel_launch: occupancy query says %d\n", per_cu); per_cu = 1; }
        (void)hipGetLastError();
        grid = cus * 1;
        if (grid > 256) grid = 256;
    }
    if (grid < 0) return;
    if (hipMemsetAsync(d_ws, 0, 16384, stream) != hipSuccess) { fprintf(stderr, "kernel_launch: memset failed\n"); return; }
    Args a{};
    for (int i = 0; i < 35; ++i) a.in[i] = (const float*)d_in[i];
    a.out = (float*)d_out; a.ws = (unsigned char*)d_ws;
#if MK_MULTI
    for (int ph = 0; ph < NPHASE; ++ph) { a.ph_lo = ph; a.ph_hi = ph + 1; hipLaunchKernelGGL(mk_fwd, dim3(grid), dim3(512), LDS_BYTES, stream, a); }
#else
    a.ph_lo = 0; a.ph_hi = NPHASE;
    void* kargs[] = {&a};
    hipError_t e = hipLaunchCooperativeKernel((const void*)mk_fwd, dim3(grid), dim3(512), kargs, LDS_BYTES, stream);
    if (e != hipSuccess) fprintf(stderr, "kernel_launch: cooperative launch failed: %s (grid %d)\n", hipGetErrorString(e), grid);
#endif
}
```
